# Optimizing an MI355X kernel written in HIP

```python
import math
import jax, jax.numpy as jnp
from jax import lax
import numpy as np

D_MODEL = 1024
BATCH = 8
SEQ = 4096
DEPTH = 2

D_ATTN = D_MODEL // 2
HEAD_DIM = 64
N_HEADS_A = D_ATTN // HEAD_DIM
ROT_DIM = HEAD_DIM // 4
ROPE_THETA = 500000.0
DILATED_PATTERNS = ((128, 1), (512, 4), (2048, 16))
D_POOL = D_MODEL - D_ATTN
POOL_WINDOWS = (2, 4, 8, 16)
N_POOL_GROUPS = len(POOL_WINDOWS)
POOL_C = D_POOL // N_POOL_GROUPS
D_IN_EVEN = 3 * D_ATTN + D_POOL
S5_GROUP = 16
S5_GROUPS = D_MODEL // S5_GROUP
S5_STATE = 64
D_FF = ((8 * D_MODEL // 3 + 255) // 256) * 256
N_EVEN = (DEPTH + 1) // 2
N_ODD = DEPTH // 2
EPS = 1e-6

kernel_name = 'hybrid_dilated_pool_s5_macaron'


def _rmsnorm(x, g):
    xf = x.astype(jnp.float32)
    y = xf * lax.rsqrt(jnp.mean(xf * xf, axis=-1, keepdims=True) + EPS)
    return (y * g.astype(jnp.float32)).astype(x.dtype)


def _swiglu(h, w_gate, w_up, w_down):
    return (jax.nn.silu(h @ w_gate) * (h @ w_up)) @ w_down


def _rotary_tables(positions):
    inv_freq = ROPE_THETA ** (-jnp.arange(0, ROT_DIM, 2, dtype=jnp.float32) / ROT_DIM)
    ang = positions.astype(jnp.float32)[..., None] * inv_freq
    return jnp.cos(ang)[:, :, None, :], jnp.sin(ang)[:, :, None, :]


def _partial_rotary(t, cos, sin):
    half = ROT_DIM // 2
    tf = t[..., :ROT_DIM].astype(jnp.float32)
    t1, t2 = tf[..., :half], tf[..., half:]
    rot = jnp.concatenate([t1 * cos - t2 * sin, t2 * cos + t1 * sin], axis=-1).astype(t.dtype)
    return jnp.concatenate([rot, t[..., ROT_DIM:]], axis=-1)


def _dilated_window_attention(q, k, v, window, dilation):
    Bsz, S, H, Dh = q.shape
    n_back = window // dilation
    blk = n_back
    L = S // dilation
    nb = -(-L // blk)
    Lp = nb * blk

    def to_sub(t):
        return t.reshape(Bsz, L, dilation, H, Dh).transpose(0, 2, 3, 1, 4)

    qs = jnp.pad(to_sub(q), ((0, 0), (0, 0), (0, 0), (0, Lp - L), (0, 0)))
    qs = qs.reshape(Bsz, dilation, H, nb, blk, Dh)

    def windows(t):
        t = jnp.pad(to_sub(t), ((0, 0), (0, 0), (0, 0), (blk, Lp - L), (0, 0)))
        t = t.reshape(Bsz, dilation, H, nb + 1, blk, Dh)
        return jnp.concatenate([t[:, :, :, :-1], t[:, :, :, 1:]], axis=-2)

    kw, vw = windows(k), windows(v)
    scores = jnp.einsum('bdhnqe,bdhnke->bdhnqk', qs, kw,
                        preferred_element_type=jnp.float32) * (Dh ** -0.5)
    qi = jnp.arange(blk)[:, None]
    kj = jnp.arange(2 * blk)[None, :]
    delta = qi - kj + blk
    blk_idx = jnp.arange(nb)[:, None, None]
    valid = (delta >= 0) & (delta <= n_back) & (blk_idx * blk - blk + kj >= 0)
    scores = jnp.where(valid, scores, -jnp.inf)
    lse = jax.nn.logsumexp(scores, axis=-1)
    probs = jnp.exp(scores - lse[..., None])
    out = jnp.einsum('bdhnqk,bdhnke->bdhnqe', probs.astype(vw.dtype), vw)
    out = out.reshape(Bsz, dilation, H, Lp, Dh)[:, :, :, :L]
    out = out.transpose(0, 3, 1, 2, 4).reshape(Bsz, S, H, Dh)
    lse = lse.reshape(Bsz, dilation, H, Lp)[..., :L].transpose(0, 3, 1, 2).reshape(Bsz, S, H)
    return out, lse


def _multiscale_pool(p, pool_w, pool_scale):
    Bsz, S, _ = p.shape
    pf = p.astype(jnp.float32).reshape(Bsz, S, N_POOL_GROUPS, POOL_C)
    cs0 = jnp.pad(jnp.cumsum(pf, axis=1), ((0, 0), (1, 0), (0, 0), (0, 0)))
    t1 = jnp.arange(1, S + 1)
    pooled = []
    for g, w in enumerate(POOL_WINDOWS):
        upper = cs0[:, 1:, g]
        lower = jnp.pad(cs0[:, :S + 1 - w, g], ((0, 0), (w - 1, 0), (0, 0)))
        count = jnp.minimum(t1, w).astype(jnp.float32)[None, :, None]
        pooled.append((upper - lower) / count - pf[:, :, g])
    pooled = jnp.stack(pooled, axis=2)
    y = jnp.einsum('bsgc,gce->bsge', pooled, pool_w.astype(jnp.float32)).reshape(Bsz, S, D_POOL)
    return (y * pool_scale.astype(jnp.float32)).astype(p.dtype)


def _even_mixer(h, cos, sin, w_in, q_norm, k_norm, pool_w, pool_scale, w_out):
    Bsz, S, _ = h.shape
    proj = h @ w_in
    q, k, v, p = jnp.split(proj, [D_ATTN, 2 * D_ATTN, 3 * D_ATTN], axis=-1)
    shp = (Bsz, S, N_HEADS_A, HEAD_DIM)
    q = _partial_rotary(_rmsnorm(q.reshape(shp), q_norm), cos, sin)
    k = _partial_rotary(_rmsnorm(k.reshape(shp), k_norm), cos, sin)
    v = v.reshape(shp)
    outs, lses = [], []
    for window, dilation in DILATED_PATTERNS:
        o, l = _dilated_window_attention(q, k, v, window, dilation)
        outs.append(o)
        lses.append(l)
    wts = jax.nn.softmax(jnp.stack(lses, axis=0), axis=0)
    attn = jnp.einsum('pbsh,pbshe->bshe', wts, jnp.stack(outs, axis=0).astype(jnp.float32))
    attn = attn.reshape(Bsz, S, D_ATTN).astype(h.dtype)
    pool = _multiscale_pool(p, pool_w, pool_scale)
    return jnp.concatenate([attn, pool], axis=-1) @ w_out


def _s5_ssm(u, a_re, a_im, log_dt, b_re, b_im, c_re, c_im, d_skip):
    Bsz, S, _ = u.shape
    f32 = jnp.float32
    uf = u.astype(f32).reshape(Bsz, S, S5_GROUPS, S5_GROUP)
    lam_re = jnp.minimum(a_re.astype(f32), -1e-4)
    lam_im = a_im.astype(f32)
    dt = jnp.exp(log_dt.astype(f32))[:, None]
    mag = jnp.exp(lam_re * dt)
    lbar_re = mag * jnp.cos(lam_im * dt)
    lbar_im = mag * jnp.sin(lam_im * dt)
    den = lam_re * lam_re + lam_im * lam_im
    nre = lbar_re - 1.0
    coef_re = (nre * lam_re + lbar_im * lam_im) / den
    coef_im = (lbar_im * lam_re - nre * lam_im) / den
    br, bi = b_re.astype(f32), b_im.astype(f32)
    bb_re = coef_re[..., None] * br - coef_im[..., None] * bi
    bb_im = coef_re[..., None] * bi + coef_im[..., None] * br
    bu_re = jnp.einsum('bsgc,gpc->bsgp', uf, bb_re)
    bu_im = jnp.einsum('bsgc,gpc->bsgp', uf, bb_im)
    a_seq_re = jnp.broadcast_to(lbar_re, (1, S, S5_GROUPS, S5_STATE))
    a_seq_im = jnp.broadcast_to(lbar_im, (1, S, S5_GROUPS, S5_STATE))

    def combine(e1, e2):
        ar1, ai1, br1, bi1 = e1
        ar2, ai2, br2, bi2 = e2
        return (ar2 * ar1 - ai2 * ai1,
                ar2 * ai1 + ai2 * ar1,
                ar2 * br1 - ai2 * bi1 + br2,
                ar2 * bi1 + ai2 * br1 + bi2)

    _, _, h_re, h_im = lax.associative_scan(combine, (a_seq_re, a_seq_im, bu_re, bu_im), axis=1)
    y = (jnp.einsum('bsgp,gcp->bsgc', h_re, c_re.astype(f32))
         - jnp.einsum('bsgp,gcp->bsgc', h_im, c_im.astype(f32)))
    return y.reshape(Bsz, S, D_MODEL) + d_skip.astype(f32) * uf.reshape(Bsz, S, D_MODEL)


def _odd_mixer(h, a_re, a_im, log_dt, b_re, b_im, c_re, c_im, d_skip, w_glu):
    y = _s5_ssm(h, a_re, a_im, log_dt, b_re, b_im, c_re, c_im, d_skip)
    z = jax.nn.gelu(y).astype(h.dtype)
    val, gate = jnp.split(z @ w_glu, 2, axis=-1)
    return val * jax.nn.sigmoid(gate)


def setup_inputs(seed: int = 0) -> dict:
    key = jax.random.key(seed)
    ks = jax.random.split(key, 24)
    f32 = jnp.float32

    def nrm(k, shape, scale):
        return scale * jax.random.normal(k, shape, f32)

    x = nrm(ks[0], (BATCH, SEQ, D_MODEL), 1.0)
    positions = (jax.random.randint(ks[1], (BATCH, 1), 0, 1024, jnp.int32)
                 + jnp.arange(SEQ, dtype=jnp.int32)[None, :])
    ffn_norm = 1.0 + nrm(ks[2], (DEPTH, 2, D_MODEL), 0.02)
    ffn_w_gate = nrm(ks[3], (DEPTH, 2, D_MODEL, D_FF), D_MODEL ** -0.5)
    ffn_w_up = nrm(ks[4], (DEPTH, 2, D_MODEL, D_FF), D_MODEL ** -0.5)
    ffn_w_down = nrm(ks[5], (DEPTH, 2, D_FF, D_MODEL), D_FF ** -0.5)
    mix_norm = 1.0 + nrm(ks[6], (DEPTH, D_MODEL), 0.02)
    ev_w_in = nrm(ks[7], (N_EVEN, D_MODEL, D_IN_EVEN), D_MODEL ** -0.5)
    ev_q_norm = 1.0 + nrm(ks[8], (N_EVEN, HEAD_DIM), 0.02)
    ev_k_norm = 1.0 + nrm(ks[9], (N_EVEN, HEAD_DIM), 0.02)
    ev_pool_w = nrm(ks[10], (N_EVEN, N_POOL_GROUPS, POOL_C, POOL_C), POOL_C ** -0.5)
    ev_pool_scale = 1.0 + nrm(ks[11], (N_EVEN, D_POOL), 0.02)
    ev_w_out = nrm(ks[12], (N_EVEN, D_MODEL, D_MODEL), D_MODEL ** -0.5)
    s5_a_re = -0.5 + nrm(ks[13], (N_ODD, S5_GROUPS, S5_STATE), 0.01)
    s5_a_im = (math.pi * jnp.arange(S5_STATE, dtype=f32))[None, None, :] + nrm(ks[14], (N_ODD, S5_GROUPS, S5_STATE), 0.01)
    s5_log_dt = jax.random.uniform(ks[15], (N_ODD, S5_GROUPS), f32, math.log(0.001), math.log(0.1))
    s5_b_re = nrm(ks[16], (N_ODD, S5_GROUPS, S5_STATE, S5_GROUP), (2 * S5_GROUP) ** -0.5)
    s5_b_im = nrm(ks[17], (N_ODD, S5_GROUPS, S5_STATE, S5_GROUP), (2 * S5_GROUP) ** -0.5)
    s5_c_re = nrm(ks[18], (N_ODD, S5_GROUPS, S5_GROUP, S5_STATE), S5_STATE ** -0.5)
    s5_c_im = nrm(ks[19], (N_ODD, S5_GROUPS, S5_GROUP, S5_STATE), S5_STATE ** -0.5)
    s5_d = nrm(ks[20], (N_ODD, D_MODEL), 1.0)
    s5_w_glu = nrm(ks[21], (N_ODD, D_MODEL, 2 * D_MODEL), D_MODEL ** -0.5)
    return {'x': x, 'positions': positions,
            'ffn_norm': ffn_norm, 'ffn_w_gate': ffn_w_gate, 'ffn_w_up': ffn_w_up, 'ffn_w_down': ffn_w_down,
            'mix_norm': mix_norm,
            'ev_w_in': ev_w_in, 'ev_q_norm': ev_q_norm, 'ev_k_norm': ev_k_norm,
            'ev_pool_w': ev_pool_w, 'ev_pool_scale': ev_pool_scale, 'ev_w_out': ev_w_out,
            's5_a_re': s5_a_re, 's5_a_im': s5_a_im, 's5_log_dt': s5_log_dt,
            's5_b_re': s5_b_re, 's5_b_im': s5_b_im, 's5_c_re': s5_c_re, 's5_c_im': s5_c_im,
            's5_d': s5_d, 's5_w_glu': s5_w_glu}


def reference(x, positions, ffn_norm, ffn_w_gate, ffn_w_up, ffn_w_down, mix_norm,
              ev_w_in, ev_q_norm, ev_k_norm, ev_pool_w, ev_pool_scale, ev_w_out,
              s5_a_re, s5_a_im, s5_log_dt, s5_b_re, s5_b_im, s5_c_re, s5_c_im,
              s5_d, s5_w_glu):
    cos, sin = _rotary_tables(positions)
    for layer in range(DEPTH):
        x = x + 0.5 * _swiglu(_rmsnorm(x, ffn_norm[layer, 0]), ffn_w_gate[layer, 0],
                              ffn_w_up[layer, 0], ffn_w_down[layer, 0])
        h = _rmsnorm(x, mix_norm[layer])
        j = layer // 2
        if layer % 2 == 0:
            mixed = _even_mixer(h, cos, sin, ev_w_in[j], ev_q_norm[j], ev_k_norm[j],
                                ev_pool_w[j], ev_pool_scale[j], ev_w_out[j])
        else:
            mixed = _odd_mixer(h, s5_a_re[j], s5_a_im[j], s5_log_dt[j], s5_b_re[j], s5_b_im[j],
                               s5_c_re[j], s5_c_im[j], s5_d[j], s5_w_glu[j])
        x = x + mixed.astype(x.dtype)
        x = x + 0.5 * _swiglu(_rmsnorm(x, ffn_norm[layer, 1]), ffn_w_gate[layer, 1],
                              ffn_w_up[layer, 1], ffn_w_down[layer, 1])
    return x
```

```cpp
#include <hip/hip_runtime.h>
#include <hip/hip_cooperative_groups.h>
#include <cstdio>
#include <cstdint>
#include <cmath>
__device__ __forceinline__ int ltid() { int t = threadIdx.x; asm volatile("" : "+v"(t)); return t; }
__device__ __forceinline__ int lbid() { int b = blockIdx.x; asm volatile("" : "+s"(b)); return b; }
namespace pg8 {
#define PG8_LAS __attribute__((address_space(3)))
typedef unsigned short bf16_t;
typedef short bf16x8 __attribute__((ext_vector_type(8)));
typedef float f32x4 __attribute__((ext_vector_type(4)));
typedef unsigned u32x4 __attribute__((ext_vector_type(4)));
constexpr int BM = 256, BK = 64, HALF = 128, HTB = HALF * BK * 2  , STAGE_BYTES = 8 * HTB, NXCD = 8, WGM = 8;

__host__ __device__ __forceinline__ int lds_byte(int r, int c) { const int st = (r >> 4) * 2 + (c >> 5), rr = r & 15, cc = c & 31, ob = rr * 64 + cc * 2; return st * 1024 + (ob ^ (((ob >> 9) & 1) << 5)); }
__host__ __device__ __forceinline__ void stage_rc(int b, int& R, int& C) { const int st = b / 1024, sb = b % 1024, swz = sb ^ (((sb >> 9) & 1) << 5); R = (st >> 1) * 16 + swz / 64; C = (st & 1) * 32 + (swz % 64) / 2; }
__host__ __device__ __forceinline__ int perm32(int rho) { const int n = rho >> 4, i = rho & 15; return 8 * (i >> 2) + 4 * n + (i & 3); }

struct Unit { int pm, pn; };
struct Gemm { const bf16_t* A; const bf16_t* Bt; int M, N, K; int lda = 0, ldb = 0; };

struct StaticOrder {
    int nM, nN, nwg, G, c;
    __host__ __device__ void init(int M, int N, int G_, int c_) { nM = M / BM; nN = N / BM; nwg = nM * nN; G = G_; c = c_; }
    __host__ __device__ bool next(int i, Unit& u) const {
        const long L = (long)i * G + c; if (L >= nwg) return false;
        int wgid = (int)L; { const int q = nwg / NXCD, r = nwg % NXCD, xcd = wgid % NXCD, off = wgid / NXCD; wgid = (xcd < r ? xcd * (q + 1) : r * (q + 1) + (xcd - r) * q) + off; }
        const int nig = WGM * nN, gid = wgid / nig, fm = gid * WGM, gsz = (nM - fm) < WGM ? (nM - fm) : WGM;
        u.pm = fm + ((wgid % nig) % gsz); u.pn = (wgid % nig) / gsz; return true;
    }
    __device__ __forceinline__ void a_ready(const Unit&) const {}
    __device__ __forceinline__ void done(const Unit&) const {}
};

__device__ __forceinline__ unsigned cvt_pk_bf16(float lo, float hi) { unsigned r; asm volatile("v_cvt_pk_bf16_f32 %0, %1, %2" : "=v"(r) : "v"(lo), "v"(hi)); return r; }
typedef float f32x2 __attribute__((ext_vector_type(2)));
typedef unsigned u32x2 __attribute__((ext_vector_type(2)));
__device__ __forceinline__ float fast_exp2(float x) { return __builtin_amdgcn_exp2f(x); }
__device__ __forceinline__ float fast_rcp(float x) { return __builtin_amdgcn_rcpf(x); }
__device__ __forceinline__ float sigmoidf_(float x) { return fast_rcp(1.0f + fast_exp2(-1.4426950408889634f * x)); }
__device__ __forceinline__ float xsum16(float v) { const auto r = __builtin_amdgcn_permlane16_swap(__float_as_uint(v), __float_as_uint(v), false, false); return __uint_as_float(r[0]) + __uint_as_float(r[1]); }
__device__ __forceinline__ float xsum32(float v) { const auto r = __builtin_amdgcn_permlane32_swap(__float_as_uint(v), __float_as_uint(v), false, false); return __uint_as_float(r[0]) + __uint_as_float(r[1]); }
__device__ __forceinline__ float xchg16(float v, int fq) { const auto r = __builtin_amdgcn_permlane16_swap(__float_as_uint(v), __float_as_uint(v), false, false); return (fq & 1) ? __uint_as_float(r[0]) : __uint_as_float(r[1]); }
__device__ __forceinline__ float row_rstd(const float* SS, int row, int fq) {
    const f32x4* q = (const f32x4*)(SS + (size_t)row * 32 + 8 * fq);
    const f32x4 a = q[0], b = q[1];
    float s = ((a[0] + a[1]) + (a[2] + a[3])) + ((b[0] + b[1]) + (b[2] + b[3]));
    s = xsum16(s); s = xsum32(s);
    return __builtin_amdgcn_rsqf(s * (1.0f / 1024.0f) + 1e-6f);
}
__device__ __forceinline__ float rstd_from(const f32x4& a, const f32x4& b) {
    float s = ((a[0] + a[1]) + (a[2] + a[3])) + ((b[0] + b[1]) + (b[2] + b[3]));
    s = xsum16(s); s = xsum32(s);
    return __builtin_amdgcn_rsqf(s * (1.0f / 1024.0f) + 1e-6f);
}
struct EpiSwiGLU {
    static constexpr bool PERM = true, AFTER_DRAIN = false;
    struct State { float rs[2][4]; int pm; }; static __device__ __forceinline__ void init(State& s) { s.pm = -1; }
    bf16_t* ACT; const float* SS;
    __device__ __forceinline__ void operator()(const f32x4 (&acc)[2][2][4][2], const Unit& u, int wr, int wc, int fr, int fq, State& est) const {
        const int col0 = u.pn * 128 + wc * 32 + 8 * fq;
        if (est.pm != u.pm) {
            f32x4 sa[2][4], sb[2][4];
#pragma unroll
            for (int ai = 0; ai < 2; ++ai)
#pragma unroll
                for (int m = 0; m < 4; ++m) { const f32x4* q = (const f32x4*)(SS + (size_t)(u.pm * BM + ai * HALF + wr * 64 + m * 16 + fr) * 32 + 8 * fq); sa[ai][m] = q[0]; sb[ai][m] = q[1]; }
#pragma unroll
            for (int ai = 0; ai < 2; ++ai)
#pragma unroll
                for (int m = 0; m < 4; ++m) est.rs[ai][m] = rstd_from(sa[ai][m], sb[ai][m]);
            est.pm = u.pm; }
#pragma unroll
        for (int ai = 0; ai < 2; ++ai)
#pragma unroll
            for (int m = 0; m < 4; ++m) {
                const int row = u.pm * BM + ai * HALF + wr * 64 + m * 16 + fr;
                const float rs = est.rs[ai][m], c1 = -1.4426950408889634f * rs, rs2 = rs * rs;
                f32x4 v[2];
#pragma unroll
                for (int n = 0; n < 2; ++n) { const f32x4 a = acc[ai][0][m][n], b = acc[ai][1][m][n]; const f32x4 t = a * c1; f32x4 r;
#pragma unroll
                    for (int j = 0; j < 4; ++j) r[j] = fast_rcp(1.0f + fast_exp2(t[j]));
                    v[n] = (a * b) * (r * rs2); }
                u32x4 w; w.x = cvt_pk_bf16(v[0][0], v[0][1]); w.y = cvt_pk_bf16(v[0][2], v[0][3]); w.z = cvt_pk_bf16(v[1][0], v[1][1]); w.w = cvt_pk_bf16(v[1][2], v[1][3]);
                *(u32x4*)(ACT + (size_t)row * 2816 + col0) = w;
            }
    }
};
struct EpiResid {
    static constexpr bool PERM = false, AFTER_DRAIN = false;
    struct State {}; static __device__ __forceinline__ void init(State&) {}
    float* outf; bf16_t* XB; float* SS; float alpha;
    __device__ __forceinline__ void operator()(const f32x4 (&acc)[2][2][4][2], const Unit& u, int wr, int wc, int fr, int fq, State& est) const {
        const int col0 = u.pn * BM + wc * 32 + 4 * fq;
        u32x2 bq[2][4][2][2];
#pragma unroll
        for (int ai = 0; ai < 2; ++ai)
#pragma unroll
            for (int m = 0; m < 4; ++m) { const size_t off = (size_t)(u.pm * BM + ai * HALF + wr * 64 + m * 16 + fr) * 1024 + col0;
#pragma unroll
                for (int bj = 0; bj < 2; ++bj)
#pragma unroll
                    for (int n = 0; n < 2; ++n) bq[ai][m][bj][n] = *(const u32x2*)(XB + off + bj * HALF + n * 16); }
#pragma unroll
        for (int ai = 0; ai < 2; ++ai) {
#pragma unroll
            for (int m = 0; m < 4; ++m) {
                const int row = u.pm * BM + ai * HALF + wr * 64 + m * 16 + fr;
                const size_t off = (size_t)row * 1024 + col0;
#pragma unroll
                for (int bj = 0; bj < 2; ++bj) {
                    float ss = 0.f;
#pragma unroll
                    for (int n = 0; n < 2; ++n) {
                        const u32x2 bb = bq[ai][m][bj][n];
                        f32x4 o; o[0] = __uint_as_float(bb.x << 16) + acc[ai][bj][m][n][0] * alpha; o[1] = __uint_as_float(bb.x & 0xffff0000u) + acc[ai][bj][m][n][1] * alpha;
                        o[2] = __uint_as_float(bb.y << 16) + acc[ai][bj][m][n][2] * alpha; o[3] = __uint_as_float(bb.y & 0xffff0000u) + acc[ai][bj][m][n][3] * alpha;
                        if (outf) { __builtin_nontemporal_store(o, (f32x4*)(outf + off + bj * HALF + n * 16)); continue; }
                        u32x2 w; w.x = cvt_pk_bf16(o[0], o[1]); w.y = cvt_pk_bf16(o[2], o[3]);
                        *(u32x2*)(XB + off + bj * HALF + n * 16) = w;
                        ss += (o[0] * o[0] + o[1] * o[1]) + (o[2] * o[2] + o[3] * o[3]);
                    }
                    if (outf) continue;
                    ss = xsum16(ss); ss = xsum32(ss);
                    if (fq == 0) SS[(size_t)row * 32 + 8 * u.pn + 4 * bj + wc] = ss;
                }
            }
        }
    }
};
struct EpiGLU {
    static constexpr bool PERM = false, AFTER_DRAIN = false;
    struct State {}; static __device__ __forceinline__ void init(State&) {}
    bf16_t* XB; float* SS;
    __device__ __forceinline__ void operator()(const f32x4 (&acc)[2][2][4][2], const Unit& u, int wr, int wc, int fr, int fq, State& est) const {
        const int col0 = u.pn * 128 + wc * 32 + 4 * fq;
        u32x2 bq[2][4][2];
#pragma unroll
        for (int ai = 0; ai < 2; ++ai)
#pragma unroll
            for (int m = 0; m < 4; ++m) { const size_t off = (size_t)(u.pm * BM + ai * HALF + wr * 64 + m * 16 + fr) * 1024 + col0;
#pragma unroll
                for (int n = 0; n < 2; ++n) bq[ai][m][n] = *(const u32x2*)(XB + off + n * 16); }
#pragma unroll
        for (int ai = 0; ai < 2; ++ai) {
#pragma unroll
            for (int m = 0; m < 4; ++m) {
                const int row = u.pm * BM + ai * HALF + wr * 64 + m * 16 + fr;
                const size_t off = (size_t)row * 1024 + col0;
                float ss = 0.f;
#pragma unroll
                for (int n = 0; n < 2; ++n) {
                    const u32x2 bb = bq[ai][m][n]; const f32x4 tt = acc[ai][1][m][n] * (-1.4426950408889634f); f32x4 r, bv;
#pragma unroll
                    for (int j = 0; j < 4; ++j) r[j] = fast_rcp(1.0f + fast_exp2(tt[j]));
                    bv[0] = __uint_as_float(bb.x << 16); bv[1] = __uint_as_float(bb.x & 0xffff0000u); bv[2] = __uint_as_float(bb.y << 16); bv[3] = __uint_as_float(bb.y & 0xffff0000u);
                    const f32x4 o = bv + acc[ai][0][m][n] * r;
                    u32x2 w; w.x = cvt_pk_bf16(o[0], o[1]); w.y = cvt_pk_bf16(o[2], o[3]);
                    *(u32x2*)(XB + off + n * 16) = w;
                    ss += (o[0] * o[0] + o[1] * o[1]) + (o[2] * o[2] + o[3] * o[3]);
                }
                ss = xsum16(ss); ss = xsum32(ss);
                if (fq == 0) SS[(size_t)row * 32 + 4 * u.pn + wc] = ss;
            }
        }
    }
};
struct EpiQKVP {
    static constexpr bool PERM = true, AFTER_DRAIN = false;
    struct State { float r0, r1, r2, r3, r4, r5, r6, r7; int pm; }; static __device__ __forceinline__ void init(State& s) { s.pm = -1; }
    bf16_t* O; const float* SS; const float* qn; const float* kn; const float* CS; float qscale;
    __device__ __forceinline__ void operator()(const f32x4 (&acc)[2][2][4][2], const Unit& u, int wr, int wc, int fr, int fq, State& est) const {
        const int kind = u.pn >> 1;
        const int cb = u.pn * BM + wc * 64 + 8 * fq;
        const float* gsrc = (kind == 0) ? qn : kn;
        f32x4 gv[2][2];
#pragma unroll
        for (int bj = 0; bj < 2; ++bj)
#pragma unroll
            for (int n = 0; n < 2; ++n) gv[bj][n] = *(const f32x4*)(gsrc + 32 * bj + 8 * fq + 4 * n);
        if (est.pm != u.pm) {
            float t[2][4];
#pragma unroll
            for (int ai = 0; ai < 2; ++ai) { f32x4 sa[4], sb[4];
#pragma unroll
                for (int m = 0; m < 4; ++m) { const f32x4* q = (const f32x4*)(SS + (size_t)(u.pm * BM + ai * HALF + wr * 64 + m * 16 + fr) * 32 + 8 * fq); sa[m] = q[0]; sb[m] = q[1]; }
#pragma unroll
                for (int m = 0; m < 4; ++m) t[ai][m] = rstd_from(sa[m], sb[m]); }
            est.r0 = t[0][0]; est.r1 = t[0][1]; est.r2 = t[0][2]; est.r3 = t[0][3]; est.r4 = t[1][0]; est.r5 = t[1][1]; est.r6 = t[1][2]; est.r7 = t[1][3]; est.pm = u.pm; }
        const float rsv[2][4] = {{est.r0, est.r1, est.r2, est.r3}, {est.r4, est.r5, est.r6, est.r7}};
#pragma unroll
        for (int aim = 0; aim < 4; ++aim) { const int ai = aim >> 1, mp = aim & 1;
            f32x4 csv[2][2], snv[2][2];
#pragma unroll
            for (int mm = 0; mm < 2; ++mm) { const size_t row = (size_t)(u.pm * BM + ai * HALF + wr * 64 + (2 * mp + mm) * 16 + fr);
#pragma unroll
                for (int n = 0; n < 2; ++n) { const f32x4 lc = *(const f32x4*)(CS + row * 16 + 4 * n), ls = *(const f32x4*)(CS + row * 16 + 8 + 4 * n);
#pragma unroll
                    for (int j = 0; j < 4; ++j) { csv[mm][n][j] = (kind < 2) ? lc[j] : 1.0f; snv[mm][n][j] = (kind < 2) ? ls[j] : 0.0f; } } }
#pragma unroll
            for (int mm = 0; mm < 2; ++mm) { const int m = 2 * mp + mm;
                const int row = u.pm * BM + ai * HALF + wr * 64 + m * 16 + fr;
                const float rs = rsv[ai][m];
                f32x4 v[2][2];
#pragma unroll
                for (int bj = 0; bj < 2; ++bj)
#pragma unroll
                    for (int n = 0; n < 2; ++n) v[bj][n] = acc[ai][bj][m][n] * rs;
                if (kind < 2) {
                    float ss = 0.f;
#pragma unroll
                    for (int bj = 0; bj < 2; ++bj)
#pragma unroll
                        for (int n = 0; n < 2; ++n) ss += (v[bj][n][0] * v[bj][n][0] + v[bj][n][1] * v[bj][n][1]) + (v[bj][n][2] * v[bj][n][2] + v[bj][n][3] * v[bj][n][3]);
                    ss = xsum16(ss); ss = xsum32(ss);
                    const float hn = __builtin_amdgcn_rsqf(ss * (1.0f / 64.0f) + 1e-6f);
#pragma unroll
                    for (int bj = 0; bj < 2; ++bj)
#pragma unroll
                        for (int n = 0; n < 2; ++n) v[bj][n] = v[bj][n] * hn * gv[bj][n];
#pragma unroll
                    for (int n = 0; n < 2; ++n) {
                        const f32x4 cs = csv[mm][n], sn = snv[mm][n];
                        f32x4 mine = v[0][n], other;
#pragma unroll
                        for (int j = 0; j < 4; ++j) other[j] = xchg16(mine[j], fq);
                        if (fq == 0) v[0][n] = mine * cs - other * sn;
                        else if (fq == 1) v[0][n] = mine * cs + other * sn;
                    }
                    if (kind == 0) {
#pragma unroll
                        for (int bj = 0; bj < 2; ++bj)
#pragma unroll
                            for (int n = 0; n < 2; ++n) v[bj][n] = v[bj][n] * qscale;
                    }
                }
#pragma unroll
                for (int bj = 0; bj < 2; ++bj) {
                    u32x4 w; w.x = cvt_pk_bf16(v[bj][0][0], v[bj][0][1]); w.y = cvt_pk_bf16(v[bj][0][2], v[bj][0][3]); w.z = cvt_pk_bf16(v[bj][1][0], v[bj][1][1]); w.w = cvt_pk_bf16(v[bj][1][2], v[bj][1][3]);
                    if (kind < 3) *(u32x4*)(O + ((size_t)((kind * 8 + (row >> 12)) * 8 + (u.pn & 1) * 4 + wc) * 4096 + (row & 4095)) * 64 + 32 * bj + 8 * fq) = w;
                    else *(u32x4*)(O + (size_t)96 * 1048576 / 2 + (size_t)row * 512 + (u.pn & 1) * 256 + wc * 64 + 32 * bj + 8 * fq) = w;
                }
            }
        }
    }
};

struct BatchedOrder {
    int G, c;
    __device__ __forceinline__ bool next(int i, Unit& u) const { const int L = i * G + c; if (L >= 512) return false; const int xcd = L & 7, q = L >> 3, g = xcd * 8 + (q >> 3), r = q & 7; u.pm = 4 * g + (r & 3); u.pn = 2 * g + (r >> 2); return true; }
    __device__ __forceinline__ void a_ready(const Unit&) const {}
    __device__ __forceinline__ void done(const Unit&) const {}
};
__device__ __forceinline__ float gelu_tanh_(float x) { const float z = 1.5957691216057308f * (x + 0.044715f * x * x * x); return x * fast_rcp(1.0f + fast_exp2(-1.4426950408889634f * z)); }
struct EpiS5 {
    static constexpr bool PERM = true, AFTER_DRAIN = false;
    struct State {}; static __device__ __forceinline__ void init(State&) {}
    bf16_t* Z;
    __device__ __forceinline__ void operator()(const f32x4 (&acc)[2][2][4][2], const Unit& u, int wr, int wc, int fr, int fq, State& est) const {
        const int g = u.pm >> 2;
#pragma unroll
        for (int ai = 0; ai < 2; ++ai)
#pragma unroll
            for (int m = 0; m < 4; ++m) {
                const int rr = (u.pm & 3) * BM + ai * HALF + wr * 64 + m * 16 + fr;
#pragma unroll
                for (int bj = 0; bj < 2; ++bj) {
                    const int t = 16 * (u.pn & 1) + 8 * bj + 2 * wc + (fq >> 1);
                    f32x4 v[2];
#pragma unroll
                    for (int n = 0; n < 2; ++n) { const f32x4 x = acc[ai][bj][m][n]; const f32x4 tt = x * ((x * x) * (-0.10294324f) + (-2.3022082f)); f32x4 r;
#pragma unroll
                        for (int j = 0; j < 4; ++j) r[j] = fast_rcp(1.0f + fast_exp2(tt[j]));
                        v[n] = x * r; }
                    u32x4 w; w.x = cvt_pk_bf16(v[0][0], v[0][1]); w.y = cvt_pk_bf16(v[0][2], v[0][3]); w.z = cvt_pk_bf16(v[1][0], v[1][1]); w.w = cvt_pk_bf16(v[1][2], v[1][3]);
                    *(u32x4*)(Z + ((size_t)rr * 32 + t) * 1024 + 16 * g + 8 * (fq & 1)) = w;
                }
            }
    }
};

struct S1Order {
    int G, c;
    __device__ __forceinline__ bool next(int i, Unit& u) const { const int L = i * G + c; if (L >= 256) return false; const int xcd = L & 7, q = L >> 3, g = xcd * 8 + (q >> 2); u.pm = 4 * g + (q & 3); u.pn = g; return true; }
    __device__ __forceinline__ void a_ready(const Unit&) const {}
    __device__ __forceinline__ void done(const Unit&) const {}
};
struct EpiS1 {
    static constexpr bool PERM = false, AFTER_DRAIN = true;
    struct State {}; static __device__ __forceinline__ void init(State&) {}
    bf16_t* UG; const float* A32;
    __device__ __forceinline__ void fused(f32x4 (&acc)[2][2][4][2], const Unit& u, int wr, int wc, int fr, int fq, PG8_LAS unsigned char* lds, int wid, int lane) const {
        PG8_LAS float* E = (PG8_LAS float*)lds;
        PG8_LAS f32x2* ENDS = (PG8_LAS f32x2*)(lds + 131072);
        const int g = u.pn;
#pragma unroll
        for (int ai = 0; ai < 2; ++ai)
#pragma unroll
            for (int m = 0; m < 4; ++m) { const int r = ai * HALF + wr * 64 + m * 16 + fr;
#pragma unroll
                for (int n = 0; n < 2; ++n) *(PG8_LAS f32x4*)(E + r * 128 + ((wc * 32 + 16 * n + 4 * fq) ^ ((r & 7) << 2))) = acc[ai][0][m][n]; }
        asm volatile("s_waitcnt lgkmcnt(0)" ::: "memory"); __builtin_amdgcn_s_barrier(); asm volatile("" ::: "memory");
        const int bb = wid >> 2, seg = wid & 3, p = lane;
        const float ar = A32[(g * 64 + p) * 2], ai_ = A32[(g * 64 + p) * 2 + 1];
        float lr[32], li[32]; float hr = 0.f, hi = 0.f;
#pragma unroll
        for (int k = 0; k < 32; ++k) { const int r = 128 * bb + 32 * seg + k; lr[k] = hr; li[k] = hi;
            const float er = E[r * 128 + (p ^ ((r & 7) << 2))], ei = E[r * 128 + ((64 + p) ^ ((r & 7) << 2))];
            const float nr = ar * hr - ai_ * hi + er, ni = ar * hi + ai_ * hr + ei; hr = nr; hi = ni; }
        { f32x2 e; e.x = hr; e.y = hi; ENDS[(bb * 4 + seg) * 64 + p] = e; }
        float br = ar, bi = ai_;
#pragma unroll
        for (int q = 0; q < 5; ++q) { const float tr = br * br - bi * bi, ti = 2.0f * br * bi; br = tr; bi = ti; }
        asm volatile("s_waitcnt lgkmcnt(0)" ::: "memory"); __builtin_amdgcn_s_barrier(); asm volatile("" ::: "memory");
        float cr = 0.f, ci = 0.f;
        for (int jj = 0; jj < seg; ++jj) { const f32x2 e = ENDS[(bb * 4 + jj) * 64 + p]; const float nr = br * cr - bi * ci + e.x, ni = br * ci + bi * cr + e.y; cr = nr; ci = ni; }
        bf16_t* dst0 = UG + ((size_t)g * 1024 + (u.pm & 3) * 256 + 128 * bb + 32 * seg) * 640 + 512 + p;
#pragma unroll
        for (int k = 0; k < 32; ++k) { bf16_t* dst = dst0 + (size_t)k * 640;
            dst[0] = (bf16_t)(cvt_pk_bf16(lr[k] + cr, 0.f) & 0xffffu); dst[64] = (bf16_t)(cvt_pk_bf16(li[k] + ci, 0.f) & 0xffffu);
            const float nr = ar * cr - ai_ * ci, ni = ar * ci + ai_ * cr; cr = nr; ci = ni; }
    }
};
template <class Epi, class Sched, bool ALIGN_EPI = false, bool SP2 = false>
__device__ __forceinline__ void gemm_phase(PG8_LAS unsigned char* lds, const Gemm g, const Sched& S, const Epi& E) {
    const int tid = ltid(), wid = __builtin_amdgcn_readfirstlane(tid >> 6), lane = tid & 63, wr = wid >> 2, wc = wid & 3, fr = lane & 15, fq = lane >> 4;
    const int K = g.K, nt = K / BK, LDA = g.lda ? g.lda : g.K, LDB = g.ldb ? g.ldb : g.K;
    unsigned voffA[2], voffB[2];
#pragma unroll
    for (int i = 0; i < 2; ++i) { int R, C; stage_rc(tid * 16 + i * 8192, R, C); const int Rb = Epi::PERM ? ((R & ~31) + perm32(R & 31)) : R;
        voffA[i] = (unsigned)(R * LDA + C) * 2u; voffB[i] = (unsigned)(Rb * LDB + C) * 2u; }
    const size_t kstep = (size_t)(BK * 2);
    const size_t hstepA = (size_t)HALF * LDA * 2, hstepB = (size_t)HALF * LDB * 2;
    const size_t tstepA = 2 * hstepA, tstepB = 2 * hstepB;
    const unsigned ldsw = (unsigned)wid * 1024u;
    const int aoff = lds_byte(wr * 64 + fr, fq * 8), boff = lds_byte(wc * 32 + fr, fq * 8);
#define PG8_SA(b, h) (((b) * 2 + (h)) * HTB)
#define PG8_SB(b, h) ((4 + (b) * 2 + (h)) * HTB)
#define PG8_STAGE(bufoff, gbase, voff) do { _Pragma("unroll") for (int _i = 0; _i < 2; ++_i) \
        __builtin_amdgcn_global_load_lds((const unsigned*)((const char*)(gbase) + (voff)[_i]), (PG8_LAS unsigned*)(lds + (bufoff) + ldsw + _i * 8192), 16, 0, 0); } while (0)
#define PG8_LDA(dst, b, h) do { _Pragma("unroll") for (int m = 0; m < 4; ++m) _Pragma("unroll") for (int k = 0; k < 2; ++k) dst[m][k] = *(const PG8_LAS bf16x8*)(lds + PG8_SA(b, h) + aoff + m * 2048 + k * 1024); } while (0)
#define PG8_LDB(dst, b, h) do { _Pragma("unroll") for (int n = 0; n < 2; ++n) _Pragma("unroll") for (int k = 0; k < 2; ++k) dst[n][k] = *(const PG8_LAS bf16x8*)(lds + PG8_SB(b, h) + boff + n * 2048 + k * 1024); } while (0)
#define PG8_MMA(ai, bj, At, Bt) do { __builtin_amdgcn_s_setprio(1); _Pragma("unroll") for (int m = 0; m < 4; ++m) _Pragma("unroll") for (int n = 0; n < 2; ++n) _Pragma("unroll") for (int k = 0; k < 2; ++k) \
        acc[ai][bj][m][n] = __builtin_amdgcn_mfma_f32_16x16x32_bf16(Bt[n][k], At[m][k], acc[ai][bj][m][n], 0, 0, 0); __builtin_amdgcn_s_setprio(0); } while (0)
#define PG8_WAIT_V(n) asm volatile("s_waitcnt vmcnt(" #n ")" ::: "memory")
#define PG8_WAIT_L(n) asm volatile("s_waitcnt lgkmcnt(" #n ")" ::: "memory")
#define PG8_BAR __builtin_amdgcn_s_barrier()
#define PG8_SCHED __builtin_amdgcn_sched_barrier(0)
    Unit cur, nxt; int ui = 0;
    if (!S.next(0, cur)) return;
    f32x4 acc[2][2][4][2];
    typename Epi::State est; Epi::init(est);
#pragma unroll
    for (int a = 0; a < 2; ++a)
#pragma unroll
        for (int b = 0; b < 2; ++b)
#pragma unroll
            for (int m = 0; m < 4; ++m)
#pragma unroll
                for (int n = 0; n < 2; ++n) acc[a][b][m][n] = (f32x4){0.f, 0.f, 0.f, 0.f};
    bf16x8 At[4][2], B0[2][2], B1[2][2];
    const char* cA = (const char*)g.A + (size_t)cur.pm * tstepA; const char* cB = (const char*)g.Bt + (size_t)cur.pn * tstepB;
    S.a_ready(cur);
    if constexpr (SP2) {
        PG8_STAGE(PG8_SB(0, 0), cB, voffB); PG8_STAGE(PG8_SB(0, 1), cB + hstepB, voffB); PG8_STAGE(PG8_SA(0, 0), cA, voffA); PG8_STAGE(PG8_SA(0, 1), cA + hstepA, voffA);
        if (wr == 1) PG8_BAR;
        PG8_WAIT_V(2); PG8_BAR;
        PG8_STAGE(PG8_SB(1, 0), cB + kstep, voffB); PG8_STAGE(PG8_SA(1, 0), cA + kstep, voffA); PG8_STAGE(PG8_SB(1, 1), cB + hstepB + kstep, voffB);
        PG8_WAIT_V(6); PG8_BAR;
    } else {
        PG8_STAGE(PG8_SB(0, 0), cB, voffB); PG8_STAGE(PG8_SA(0, 0), cA, voffA); PG8_STAGE(PG8_SB(0, 1), cB + hstepB, voffB); PG8_STAGE(PG8_SA(0, 1), cA + hstepA, voffA);
        if (wr == 1) PG8_BAR;
        PG8_WAIT_V(4); PG8_BAR;
        PG8_STAGE(PG8_SB(1, 0), cB + kstep, voffB); PG8_STAGE(PG8_SA(1, 0), cA + kstep, voffA); PG8_STAGE(PG8_SB(1, 1), cB + hstepB + kstep, voffB);
        PG8_WAIT_V(6); PG8_BAR;
    }
    for (;;) {
        const bool has_next = S.next(ui + 1, nxt);
        const char* nA = has_next ? (const char*)g.A + (size_t)nxt.pm * tstepA : cA; const char* nB = has_next ? (const char*)g.Bt + (size_t)nxt.pn * tstepB : cB;
        for (int t = 0; t < nt; t += 2) {
            const bool last = (t == nt - 2);
            const char* a1 = cA + (size_t)(t + 1) * kstep;
            const char* a2 = last ? nA : cA + (size_t)(t + 2) * kstep; const char* b2 = last ? nB : cB + (size_t)(t + 2) * kstep;
            const char* a3 = a2 + kstep; const char* b3 = b2 + kstep;
            if (last && has_next) S.a_ready(nxt);
            if constexpr (SP2) {
            PG8_LDB(B0, 0, 0); PG8_LDB(B1, 0, 1); PG8_SCHED; PG8_LDA(At, 0, 0); PG8_STAGE(PG8_SA(1, 1), a1 + hstepA, voffA);
            PG8_WAIT_V(8); PG8_WAIT_L(0); PG8_BAR; PG8_MMA(0, 0, At, B0); PG8_MMA(0, 1, At, B1); PG8_BAR; PG8_SCHED;
            PG8_LDA(At, 0, 1); PG8_STAGE(PG8_SB(0, 0), b2, voffB); PG8_STAGE(PG8_SB(0, 1), b2 + hstepB, voffB); PG8_STAGE(PG8_SA(0, 0), a2, voffA);
            PG8_WAIT_V(8); PG8_WAIT_L(0); PG8_BAR; PG8_MMA(1, 0, At, B0); PG8_MMA(1, 1, At, B1); PG8_BAR; PG8_SCHED;
            PG8_LDB(B0, 1, 0); PG8_LDB(B1, 1, 1); PG8_SCHED; PG8_LDA(At, 1, 0); PG8_STAGE(PG8_SA(0, 1), a2 + hstepA, voffA);
            PG8_WAIT_V(8); PG8_WAIT_L(0); PG8_BAR; PG8_MMA(0, 0, At, B0); PG8_MMA(0, 1, At, B1); PG8_BAR; PG8_SCHED;
            PG8_LDA(At, 1, 1); PG8_STAGE(PG8_SB(1, 0), b3, voffB); PG8_STAGE(PG8_SB(1, 1), b3 + hstepB, voffB); PG8_STAGE(PG8_SA(1, 0), a3, voffA);
            PG8_WAIT_V(8); PG8_WAIT_L(0); PG8_BAR; PG8_MMA(1, 0, At, B0); PG8_MMA(1, 1, At, B1); PG8_BAR; PG8_SCHED;
            } else {
            PG8_LDB(B0, 0, 0); PG8_SCHED; PG8_LDA(At, 0, 0); PG8_STAGE(PG8_SA(1, 1), a1 + hstepA, voffA);
            PG8_WAIT_L(8); PG8_BAR; PG8_WAIT_L(0); PG8_MMA(0, 0, At, B0); PG8_BAR; PG8_SCHED;
            PG8_LDB(B1, 0, 1); PG8_STAGE(PG8_SB(0, 0), b2, voffB);
            PG8_BAR; PG8_WAIT_L(0); PG8_MMA(0, 1, At, B1); PG8_BAR;
            PG8_LDA(At, 0, 1); PG8_STAGE(PG8_SA(0, 0), a2, voffA);
            PG8_BAR; PG8_WAIT_L(0); PG8_MMA(1, 0, At, B0); PG8_BAR; PG8_SCHED;
            PG8_STAGE(PG8_SB(0, 1), b2 + hstepB, voffB);
            PG8_WAIT_V(6); PG8_BAR; PG8_MMA(1, 1, At, B1); PG8_BAR;
            PG8_LDB(B0, 1, 0); PG8_SCHED; PG8_LDA(At, 1, 0); PG8_STAGE(PG8_SA(0, 1), a2 + hstepA, voffA);
            PG8_WAIT_L(8); PG8_BAR; PG8_WAIT_L(0); PG8_MMA(0, 0, At, B0); PG8_BAR; PG8_SCHED;
            PG8_LDB(B1, 1, 1); PG8_STAGE(PG8_SB(1, 0), b3, voffB);
            PG8_BAR; PG8_WAIT_L(0); PG8_MMA(0, 1, At, B1); PG8_BAR;
            PG8_LDA(At, 1, 1); PG8_STAGE(PG8_SA(1, 0), a3, voffA);
            PG8_BAR; PG8_WAIT_L(0); PG8_MMA(1, 0, At, B0); PG8_BAR; PG8_SCHED;
            PG8_STAGE(PG8_SB(1, 1), b3 + hstepB, voffB);
            PG8_WAIT_V(6); PG8_BAR; PG8_MMA(1, 1, At, B1); PG8_BAR;
            }
        }
        if constexpr (ALIGN_EPI) { if (wr == 0) PG8_BAR; }
        if constexpr (!Epi::AFTER_DRAIN) { E(acc, cur, wr, wc, fr, fq, est); S.done(cur); }
        if (!has_next) break;
#pragma unroll
        for (int a = 0; a < 2; ++a)
#pragma unroll
            for (int b = 0; b < 2; ++b)
#pragma unroll
                for (int m = 0; m < 4; ++m)
#pragma unroll
                    for (int n = 0; n < 2; ++n) acc[a][b][m][n] = (f32x4){0.f, 0.f, 0.f, 0.f};
        cur = nxt; cA = nA; cB = nB; ++ui;
        if constexpr (ALIGN_EPI) { if (wr == 1) PG8_BAR; }
    }
    PG8_WAIT_V(0);
    if constexpr (!ALIGN_EPI) { if (wr == 0) PG8_BAR; }
    PG8_BAR;
    if constexpr (Epi::AFTER_DRAIN) { E.fused(acc, cur, wr, wc, fr, fq, lds, wid, lane); S.done(cur); }
#undef PG8_SA
#undef PG8_SB
#undef PG8_STAGE
#undef PG8_LDA
#undef PG8_LDB
#undef PG8_MMA
#undef PG8_WAIT_V
#undef PG8_WAIT_L
#undef PG8_BAR
#undef PG8_SCHED
}
}
namespace cg = cooperative_groups;
#define LAS __attribute__((address_space(3)))
typedef unsigned short bf16;
typedef short bf16x8 __attribute__((ext_vector_type(8)));
typedef short s16x4 __attribute__((ext_vector_type(4)));
typedef float f32x4 __attribute__((ext_vector_type(4)));
typedef float f32x2 __attribute__((ext_vector_type(2)));
typedef unsigned u32x4 __attribute__((ext_vector_type(4)));
typedef unsigned u32x2 __attribute__((ext_vector_type(2)));
#define DI __device__ __forceinline__
#define MFMA16(a, b, c) __builtin_amdgcn_mfma_f32_16x16x32_bf16((a), (b), (c), 0, 0, 0)

constexpr int NT_ = 32768, DM = 1024, FF = 2816, SEQ = 4096;
constexpr size_t MiB = 1u << 20;
constexpr size_t WS_WGU = 1 * MiB, WS_WD = 45 * MiB, WS_WIN = 67 * MiB, WS_WOUT = 71 * MiB, WS_WGLU = 73 * MiB, WS_PW = 77 * MiB, WS_M1 = 78 * MiB,
                 WS_W3 = 94 * MiB, WS_A32 = 134 * MiB, WS_CS = 135 * MiB, WS_SS = 137 * MiB, WS_LSE = 141 * MiB, WS_XB = 143 * MiB, WS_ACT = 207 * MiB,
                 WS_OP = 383 * MiB, WS_AO = 447 * MiB, WS_END = 511 * MiB;
constexpr size_t WS_QKVP = WS_ACT, WS_UG = WS_ACT, WS_Z = WS_ACT + 80 * MiB;
constexpr int LDS_BYTES = 139264;
constexpr double INV2PI = 0.15915494309189535;
constexpr float QSCALE = 0.125f * 1.4426950408889634f;

#ifndef DUP_A
#define DUP_A -1
#endif
#ifndef DUP_B
#define DUP_B -1
#endif
constexpr int NPROG = 17 + (DUP_A >= 0 ? 1 : 0) + (DUP_B >= 0 ? 1 : 0);
#ifndef PHMASK
#define PHMASK 511
#endif
struct Params { const float* in[22]; float* out; unsigned char* ws; };
DI unsigned char* lws(const Params& P) { const unsigned long long w = (unsigned long long)P.ws; unsigned lo = __builtin_amdgcn_readfirstlane((unsigned)w), hi = __builtin_amdgcn_readfirstlane((unsigned)(w >> 32)); asm volatile("" : "+s"(lo), "+s"(hi)); return (unsigned char*)(__attribute__((address_space(1))) unsigned char*)(((unsigned long long)hi << 32) | lo); }

DI unsigned pk2(float lo, float hi) { return pg8::cvt_pk_bf16(lo, hi); }
DI float bflo(unsigned u) { return __uint_as_float(u << 16); }
DI float bfhi(unsigned u) { return __uint_as_float(u & 0xffff0000u); }
DI float wave_sum(float v) {
#pragma unroll
    for (int o = 1; o < 64; o <<= 1) v += __shfl_xor(v, o);
    return v;
}
DI void cis_rev(double rev, float& c, float& s) { rev -= __builtin_rint(rev); const float r = (float)rev; c = __builtin_amdgcn_cosf(r); s = __builtin_amdgcn_sinf(r); }
#define LDS_WAIT() asm volatile("s_waitcnt lgkmcnt(0)" ::: "memory")
#define XB_TMO      128
#define XB_XCNT(j)  (256  + 64 * (j))
#define XB_XSUB(j)  (1280 + 64 * (j))
#define XB_XGEN(j)  (2304 + 64 * (j))
#define XB_TOP      3328
#define XB_TOPGEN   3392
#define XCD_BAR_WORDS 3456
#define XB_SPIN_CAP (1u << 18)

__device__ __forceinline__ unsigned xb_ld(unsigned* p)              { return __hip_atomic_load(p, __ATOMIC_RELAXED, __HIP_MEMORY_SCOPE_AGENT); }
__device__ __forceinline__ unsigned xb_add(unsigned* p, unsigned v) { return __hip_atomic_fetch_add(p, v, __ATOMIC_RELAXED, __HIP_MEMORY_SCOPE_AGENT); }
__device__ __forceinline__ unsigned xb_xcc_id() { return (unsigned)__builtin_amdgcn_s_getreg((3 << 11) | 20) & 0xFu; }
#define XB_SPIN(cond, bar) do { unsigned _sp = 0; while (cond) { __builtin_amdgcn_s_sleep(1); \
    if ((++_sp & 255u) == 0u) { if (xb_ld(&(bar)[XB_TMO])) break; if (_sp > XB_SPIN_CAP) { atomicAdd(&(bar)[XB_TMO], 1u); break; } } } } while (0)

struct XcdBarrier {
    unsigned* bar; unsigned x;
    volatile LAS unsigned* st;
};

__device__ __forceinline__ XcdBarrier xcd_barrier_post(unsigned* bar, volatile LAS unsigned* st) {
    XcdBarrier b; b.bar = bar; b.x = xb_xcc_id(); b.st = st;
    if (threadIdx.x == 0) (void)xb_add(&bar[XB_XCNT(b.x)], 1u);
    return b;
}
__device__ __forceinline__ void xcd_barrier_complete(unsigned* bar, unsigned x, unsigned& nloc, unsigned& nx) {
    const unsigned G = gridDim.x * gridDim.y * gridDim.z;
    unsigned sum, cnt, mine, sp = 0u;
    for (;;) {
        sum = 0u; cnt = 0u; mine = 0u;
#pragma unroll
        for (unsigned j = 0; j < 16; ++j) { const unsigned c = xb_ld(&bar[XB_XCNT(j)]); sum += c; cnt += (c > 0u) ? 1u : 0u; mine = (j == x) ? c : mine; }
        if (sum == G) break;
        __builtin_amdgcn_s_sleep(1);
        if ((++sp & 255u) == 0u) { if (xb_ld(&bar[XB_TMO])) break; if (sp > XB_SPIN_CAP) { atomicAdd(&bar[XB_TMO], 1u); break; } }
    }
    nloc = mine > 0u ? mine : 1u; nx = cnt > 0u ? cnt : 1u;
}

__device__ __forceinline__ void xcd_barrier(const XcdBarrier& b) {
    asm volatile("s_waitcnt vmcnt(0)" ::: "memory");
    __syncthreads();
    if (threadIdx.x == 0) {
        unsigned* bar = b.bar;
        __builtin_amdgcn_s_waitcnt(0);
        unsigned nloc = b.st[0], nx = b.st[1];
        if (nloc == 0u) { xcd_barrier_complete(bar, b.x, nloc, nx); b.st[0] = nloc; b.st[1] = nx; }
        const unsigned old = xb_add(&bar[XB_XSUB(b.x)], 1u);
        const unsigned gen = old / nloc;
        if (old + 1u == (gen + 1u) * nloc) {
            __builtin_amdgcn_fence(__ATOMIC_RELEASE, "agent");
            asm volatile("s_waitcnt vmcnt(0)" ::: "memory");
            const unsigned og = xb_add(&bar[XB_TOP], 1u);
            const unsigned tg = og / nx;
            if (og + 1u == (tg + 1u) * nx) xb_add(&bar[XB_TOPGEN], 1u);
            else XB_SPIN(xb_ld(&bar[XB_TOPGEN]) == tg, bar);
            __builtin_amdgcn_fence(__ATOMIC_ACQUIRE, "agent");
            xb_add(&bar[XB_XGEN(b.x)], 1u);
            asm volatile("s_waitcnt vmcnt(0)" ::: "memory");
        } else {
            XB_SPIN(xb_ld(&bar[XB_XGEN(b.x)]) == gen, bar);
            __builtin_amdgcn_fence(__ATOMIC_ACQUIRE, "agent");
            asm volatile("s_waitcnt vmcnt(0)" ::: "memory");
        }
    }
    __syncthreads();
}


struct TI { const float* W; const float* gk; bf16* WT; int K, N, dst_row0, k0, n0; };
DI void tr_decode(const Params& P, int it, TI& t) {
    bf16* WGU = (bf16*)(lws(P) + WS_WGU); bf16* WD = (bf16*)(lws(P) + WS_WD);
    if (it < 16896) { const int mtx = it / 1408, r = it % 1408, ls = mtx / 3, kind = mtx % 3;
        if (kind < 2) { const int kb = r / 88, nb = r % 88, n0 = 32 * nb, pn = n0 >> 7, j = n0 & 127;
            t.W = P.in[3 + kind] + (size_t)ls * 1024 * 2816; t.gk = P.in[2] + ls * 1024; t.WT = WGU + (size_t)ls * 5632 * 1024; t.K = 1024; t.N = 2816; t.dst_row0 = 256 * pn + j + (kind ? 128 : 0); t.k0 = 64 * kb; t.n0 = n0;
        } else { const int kb = r >> 5, nb = r & 31, n0 = 32 * nb;
            t.W = P.in[5] + (size_t)ls * 2816 * 1024; t.gk = nullptr; t.WT = WD + (size_t)ls * 1024 * 2816; t.K = 2816; t.N = 1024; t.dst_row0 = n0; t.k0 = 64 * kb; t.n0 = n0; }
    } else if (it < 16896 + 1024) { const int r = it - 16896, kb = r >> 6, nb = r & 63, n0 = 32 * nb, pn = n0 >> 8, rem = n0 & 255, hh = rem >> 6, bj = (rem & 63) >> 5;
        t.W = P.in[7]; t.gk = P.in[6]; t.WT = (bf16*)(lws(P) + WS_WIN); t.K = 1024; t.N = 2048; t.dst_row0 = 256 * pn + 128 * bj + 32 * hh; t.k0 = 64 * kb; t.n0 = n0;
    } else if (it < 16896 + 1024 + 512) { const int r = it - 17920, kb = r >> 5, nb = r & 31, n0 = 32 * nb;
        t.W = P.in[12]; t.gk = nullptr; t.WT = (bf16*)(lws(P) + WS_WOUT); t.K = 1024; t.N = 1024; t.dst_row0 = n0; t.k0 = 64 * kb; t.n0 = n0;
    } else { const int r = it - 18432, kb = r >> 6, nb = r & 63, n0 = 32 * nb; int dst;
        if (n0 < 1024) dst = 256 * (n0 >> 7) + (n0 & 127); else { const int n1 = n0 - 1024; dst = 256 * (n1 >> 7) + 128 + (n1 & 127); }
        t.W = P.in[21]; t.gk = nullptr; t.WT = (bf16*)(lws(P) + WS_WGLU); t.K = 1024; t.N = 2048; t.dst_row0 = dst; t.k0 = 64 * kb; t.n0 = n0; }
}
DI void tr_load(const TI& t, int lane, float (&v)[32]) {
    const float* src = t.W + (size_t)(t.k0 + (lane >> 5)) * t.N + t.n0 + (lane & 31);
#pragma unroll
    for (int i = 0; i < 32; ++i) v[i] = __builtin_nontemporal_load(src + (size_t)(2 * i) * t.N);
}
DI void tr_proc(const TI& t, LAS float* scr, int lane, const float (&v)[32]) {
#pragma unroll
    for (int i = 0; i < 32; ++i) scr[(2 * i + (lane >> 5)) * 33 + (lane & 31)] = v[i];
    LDS_WAIT(); asm volatile("" ::: "memory");
    const int c = lane & 7;
    f32x4 g0 = {1.f, 1.f, 1.f, 1.f}, g1 = {1.f, 1.f, 1.f, 1.f};
    if (t.gk) { g0 = *(const f32x4*)(t.gk + t.k0 + 8 * c); g1 = *(const f32x4*)(t.gk + t.k0 + 8 * c + 4); }
#pragma unroll
    for (int j = 0; j < 4; ++j) { const int n = (lane >> 3) + 8 * j; const LAS float* s = scr + (8 * c) * 33 + n;
        u32x4 o; o.x = pk2(s[0 * 33] * g0[0], s[1 * 33] * g0[1]); o.y = pk2(s[2 * 33] * g0[2], s[3 * 33] * g0[3]); o.z = pk2(s[4 * 33] * g1[0], s[5 * 33] * g1[1]); o.w = pk2(s[6 * 33] * g1[2], s[7 * 33] * g1[3]);
        *(u32x4*)(t.WT + (size_t)(t.dst_row0 + n) * t.K + t.k0 + 8 * c) = o; }
    LDS_WAIT(); asm volatile("" ::: "memory");
}

DI void s5_gen(const Params& P, LAS unsigned char* lds, int g, int q) {
    LAS f32x2* Pw = (LAS f32x2*)lds;
    LAS f32x2* Bb = Pw + 64 * 33;
    LAS f32x2* Cc = Bb + 1024;
    LAS f32x2* Cf = Cc + 1024;
    LAS float* Kt = (LAS float*)(Cf + 64);
    const int tid = ltid();
    const float* a_re = P.in[13] + g * 64; const float* a_im = P.in[14] + g * 64;
    const float dt = __expf(P.in[15][g]);
    const float* gm = P.in[6] + 1024 + 16 * g;
    const float* b_re = P.in[16] + (size_t)g * 1024; const float* b_im = P.in[17] + (size_t)g * 1024;
    const float* c_re = P.in[18] + (size_t)g * 1024; const float* c_im = P.in[19] + (size_t)g * 1024;
    const float* dsk = P.in[20] + 16 * g;
    float* A32 = (float*)(lws(P) + WS_A32);
    if (tid < 64) {
        const float lr = fminf(a_re[tid], -1e-4f), li = a_im[tid];
        const float mag = __expf(lr * dt); float c, s; cis_rev((double)li * (double)dt * INV2PI, c, s);
        const float lbr = mag * c, lbi = mag * s, den = lr * lr + li * li, nre = lbr - 1.0f;
        f32x2 cf; cf.x = (nre * lr + lbi * li) / den; cf.y = (lbi * lr - nre * li) / den; Cf[tid] = cf;
        const float m32 = __expf(32.0f * lr * dt); cis_rev(32.0 * (double)li * (double)dt * INV2PI, c, s);
        A32[(g * 64 + tid) * 2] = m32 * c; A32[(g * 64 + tid) * 2 + 1] = m32 * s;
    }
    for (int idx = tid; idx < 64 * 33; idx += 512) { const int p_ = idx / 33, n = idx % 33;
        const float lr = fminf(a_re[p_], -1e-4f), li = a_im[p_];
        const float mg = __expf((float)n * lr * dt); float c, s; cis_rev((double)n * (double)li * (double)dt * INV2PI, c, s);
        f32x2 v; v.x = mg * c; v.y = mg * s; Pw[idx] = v; }
    for (int idx = tid; idx < 1024; idx += 512) { f32x2 v; v.x = c_re[idx]; v.y = c_im[idx]; Cc[idx] = v; }
    __syncthreads();
    for (int idx = tid; idx < 1024; idx += 512) { const int p_ = idx >> 4, c_ = idx & 15; const float gg = gm[c_]; const float br = b_re[idx] * gg, bi = b_im[idx] * gg; const f32x2 cf = Cf[p_];
        f32x2 v; v.x = cf.x * br - cf.y * bi; v.y = cf.x * bi + cf.y * br; Bb[idx] = v; }
    __syncthreads();
    { const int pair = tid & 63, cl = pair >> 4, c_ = 4 * q + cl, c2 = pair & 15, tb = tid >> 6; float a[4];
#pragma unroll
      for (int i = 0; i < 4; ++i) a[i] = 0.f;
#pragma unroll 4
      for (int p_ = 0; p_ < 64; ++p_) { const f32x2 C = Cc[c_ * 64 + p_], B = Bb[p_ * 16 + c2]; const float Qx = C.x * B.x - C.y * B.y, Qy = C.x * B.y + C.y * B.x;
#pragma unroll
          for (int i = 0; i < 4; ++i) { const f32x2 L = Pw[p_ * 33 + 4 * tb + i]; a[i] += L.x * Qx - L.y * Qy; } }
      if (tb == 0 && c_ == c2) a[0] += dsk[c_] * gm[c_];
#pragma unroll
      for (int i = 0; i < 4; ++i) Kt[(4 * tb + i) * 64 + pair] = a[i]; }
    __syncthreads();
    bf16* W3 = (bf16*)(lws(P) + WS_W3) + (size_t)g * 512 * 640;
    for (int idx = tid; idx < 128 * 80; idx += 512) { const int nl = idx / 80, kc = idx % 80, t = nl >> 2, cl = nl & 3, c_ = 4 * q + cl, n = t * 16 + c_; float v[8];
        if (kc < 64) { const int s = kc >> 1, c0 = 8 * (kc & 1);
#pragma unroll
            for (int j = 0; j < 8; ++j) v[j] = (s <= t) ? Kt[(t - s) * 64 + cl * 16 + c0 + j] : 0.f;
        } else { const int kk0 = 8 * (kc - 64), ri = kk0 >> 6, p0 = kk0 & 63;
#pragma unroll
            for (int j = 0; j < 8; ++j) { const f32x2 C = Cc[c_ * 64 + p0 + j], L = Pw[(p0 + j) * 33 + t + 1];
                const float Gr = C.x * L.x - C.y * L.y, Gi = C.x * L.y + C.y * L.x; v[j] = ri ? -Gi : Gr; }
        }
        u32x4 o; o.x = pk2(v[0], v[1]); o.y = pk2(v[2], v[3]); o.z = pk2(v[4], v[5]); o.w = pk2(v[6], v[7]);
        *(u32x4*)(W3 + (size_t)n * 640 + kc * 8) = o; }
    bf16* M1 = (bf16*)(lws(P) + WS_M1) + (size_t)g * 256 * 512;
    for (int idx = tid; idx < 32 * 64; idx += 512) { const int n = 32 * q + (idx >> 6), kc = idx & 63, ri = n >> 6, p_ = n & 63, s = kc >> 1, c0 = 8 * (kc & 1); const f32x2 L = Pw[p_ * 33 + 31 - s]; float v[8];
#pragma unroll
        for (int j = 0; j < 8; ++j) { const f32x2 B = Bb[p_ * 16 + c0 + j]; v[j] = ri ? (L.x * B.y + L.y * B.x) : (L.x * B.x - L.y * B.y); }
        u32x4 o; o.x = pk2(v[0], v[1]); o.y = pk2(v[2], v[3]); o.z = pk2(v[4], v[5]); o.w = pk2(v[6], v[7]);
        *(u32x4*)(M1 + (size_t)n * 512 + kc * 8) = o; *(u32x4*)(M1 + (size_t)(128 + n) * 512 + kc * 8) = o; }
    __syncthreads();
}

DI void prologue(const Params& P, LAS unsigned char* lds) {
    const int tid = ltid(), lane = tid & 63, wave = __builtin_amdgcn_readfirstlane(tid >> 6);
    const int G = gridDim.x;
    const bool gen_first = ((lbid() >> 3) & 1) == 0;
    if (gen_first) for (int it = lbid(); it < 256; it += G) s5_gen(P, lds, it >> 2, it & 3);
    LAS float* scr = (LAS float*)(lds + wave * 8448);
    const int gw = lbid() * 8 + wave, NGW = G * 8;
    { constexpr int NIT = 19456; TI ta, tb; float va[32], vb[32]; int it = gw; bool ha = it < NIT;
      if (ha) { tr_decode(P, it, ta); tr_load(ta, lane, va); }
      while (ha) { const int itb = it + NGW; const bool hb = itb < NIT;
          if (hb) { tr_decode(P, itb, tb); tr_load(tb, lane, vb); }
          tr_proc(ta, scr, lane, va);
          if (!hb) break;
          const int ita = itb + NGW; ha = ita < NIT;
          if (ha) { tr_decode(P, ita, ta); tr_load(ta, lane, va); }
          tr_proc(tb, scr, lane, vb);
          it = ita; } }
    { const float* x = P.in[0]; bf16* XB = (bf16*)(lws(P) + WS_XB); float* SS = (float*)(lws(P) + WS_SS);
#define XROW_LOAD(v, m) do { const f32x4* xr_ = (const f32x4*)(x + (size_t)(m) * DM) + lane; _Pragma("unroll") for (int j = 0; j < 4; ++j) v[j] = __builtin_nontemporal_load(xr_ + 64 * j); } while (0)
#define XROW_PROC(v, m) do { unsigned long long* o8_ = (unsigned long long*)(XB + (size_t)(m) * DM) + lane; float s_ = 0.f; \
          _Pragma("unroll") for (int j = 0; j < 4; ++j) { s_ += (v[j][0] * v[j][0] + v[j][1] * v[j][1]) + (v[j][2] * v[j][2] + v[j][3] * v[j][3]); o8_[64 * j] = (unsigned long long)pk2(v[j][0], v[j][1]) | ((unsigned long long)pk2(v[j][2], v[j][3]) << 32); } \
          s_ = wave_sum(s_); if (lane < 32) SS[(size_t)(m) * 32 + lane] = (lane == 0) ? s_ : 0.f; } while (0)
      f32x4 c0[4], c1[4], n0[4], n1[4]; int m = gw;
      if (m < NT_) XROW_LOAD(c0, m); if (m + NGW < NT_) XROW_LOAD(c1, m + NGW);
      for (; m < NT_; m += 2 * NGW) { const int mn = m + 2 * NGW; const bool h2 = mn < NT_, h3 = mn + NGW < NT_;
          if (h2) XROW_LOAD(n0, mn); if (h3) XROW_LOAD(n1, mn + NGW);
          XROW_PROC(c0, m); if (m + NGW < NT_) XROW_PROC(c1, m + NGW);
          _Pragma("unroll") for (int j = 0; j < 4; ++j) { c0[j] = n0[j]; c1[j] = n1[j]; } }
#undef XROW_LOAD
#undef XROW_PROC
    }
    { const int* pos = (const int*)P.in[1]; float* CS = (float*)(lws(P) + WS_CS);
      for (int idx = lbid() * 512 + tid; idx < NT_ * 8; idx += G * 512) { const int t = idx >> 3, i = idx & 7;
          const float inv = exp2f(-(float)(2 * i) * (1.0f / 16.0f) * 18.931568569324174f); const float ang = (float)pos[t] * inv; float c, s; cis_rev((double)ang * INV2PI, c, s);
          CS[(size_t)t * 16 + i] = c; CS[(size_t)t * 16 + 8 + i] = s; } }
    { const float* pw = P.in[10]; bf16* PWt = (bf16*)(lws(P) + WS_PW);
      for (int idx = lbid() * 512 + tid; idx < 4 * 128 * 128; idx += G * 512) { const int g = idx >> 14, e = (idx >> 7) & 127, c = idx & 127;
          PWt[idx] = (bf16)(pk2(pw[(g * 128 + c) * 128 + e], 0.f) & 0xffffu); } }
    if (!gen_first) { __syncthreads(); for (int it = lbid(); it < 256; it += G) s5_gen(P, lds, it >> 2, it & 3); }
}

constexpr int KSTR = 72;
struct AU { int b, h, dd, r, n, pat; };
struct AQ { bf16x8 q[2]; float l0, l1; u32x2 x0[4], x1[4]; };
template <int MODE> DI void attn_load(const Params& P, const AU& u, int tid, u32x4 (&kv)[4], u32x4 (&vv)[4], AQ& aq) {
    const bf16* QKVP = (const bf16*)(lws(P) + WS_QKVP);
    { const int lane = tid & 63, w = tid >> 6, fr = lane & 15, quad = lane >> 4;
      const size_t tq = (size_t)u.b * SEQ + (size_t)(128 * u.n + 16 * w + fr) * u.dd + u.r;
#pragma unroll
      for (int ks = 0; ks < 2; ++ks) aq.q[ks] = *(const bf16x8*)(QKVP + ((size_t)(u.b * 8 + u.h) * 4096 + (size_t)(128 * u.n + 16 * w + fr) * u.dd + u.r) * 64 + 32 * ks + 8 * quad);
      if (MODE == 1) { const float* LSE = (const float*)(lws(P) + WS_LSE); const bf16* OP = (const bf16*)(lws(P) + WS_OP);
          aq.l0 = LSE[tq * 8 + u.h]; aq.l1 = LSE[(size_t)NT_ * 8 + tq * 8 + u.h];
          const bf16* s0 = OP + tq * 512 + u.h * 64 + 4 * quad; const bf16* s1 = s0 + (size_t)NT_ * 512;
#pragma unroll
          for (int db = 0; db < 4; ++db) { aq.x0[db] = *(const u32x2*)(s0 + 16 * db); aq.x1[db] = *(const u32x2*)(s1 + 16 * db); } } }
#pragma unroll
    for (int i = 0; i < 4; ++i) { const int idx = tid + 512 * i, row = idx >> 3, ch = idx & 7, m2 = 128 * u.n - 128 + row;
        kv[i] = (u32x4){0u, 0u, 0u, 0u}; vv[i] = (u32x4){0u, 0u, 0u, 0u};
        if (m2 >= 0) { const size_t tp = (size_t)m2 * u.dd + u.r; const bf16* src = QKVP + ((size_t)((8 + u.b) * 8 + u.h) * 4096 + tp) * 64 + ch * 8; kv[i] = *(const u32x4*)src; vv[i] = *(const u32x4*)(src + (size_t)64 * 4096 * 64); } }
}
DI void attn_stage(LAS unsigned char* lds, int tid, const u32x4 (&kv)[4], const u32x4 (&vv)[4]) {
    LAS bf16* Ks = (LAS bf16*)lds; LAS bf16* Vs = Ks + 256 * KSTR;
#pragma unroll
    for (int i = 0; i < 4; ++i) { const int idx = tid + 512 * i, row = idx >> 3, ch = idx & 7; *(LAS u32x4*)(Ks + row * KSTR + ch * 8) = kv[i]; *(LAS u32x4*)(Vs + row * KSTR + ch * 8) = vv[i]; }
}
template <int MODE> DI void attn_compute(const Params& P, LAS unsigned char* lds, const AU& u, int tid, const AQ& aq) {
    const int lane = tid & 63, w = __builtin_amdgcn_readfirstlane(tid >> 6), fr = lane & 15, quad = lane >> 4;
    LAS bf16* Ks = (LAS bf16*)lds; LAS bf16* Vs = Ks + 256 * KSTR;
    const bf16* QKVP = (const bf16*)(lws(P) + WS_QKVP);
    const size_t tq = (size_t)u.b * SEQ + (size_t)(128 * u.n + 16 * w + fr) * u.dd + u.r;
    bf16x8 qf[2]; qf[0] = aq.q[0]; qf[1] = aq.q[1];
    const LAS bf16* kb = Ks + (16 * w + fr) * KSTR + 8 * quad;
    bf16x8 kf[9][2];
#pragma unroll
    for (int T = 0; T < 9; ++T)
#pragma unroll
        for (int ks = 0; ks < 2; ++ks) kf[T][ks] = *(const LAS bf16x8*)(kb + 16 * T * KSTR + 32 * ks);
    LDS_WAIT();
    f32x4 st[10];
#pragma unroll
    for (int T = 0; T < 9; ++T) { const float bias = (u.n == 0 && T + w < 8) ? -INFINITY : 0.f;
        f32x4 a = {bias, bias, bias, bias}; a = MFMA16(kf[T][0], qf[0], a); a = MFMA16(kf[T][1], qf[1], a); st[T] = a; }
    st[9] = (f32x4){0.f, 0.f, 0.f, 0.f};
    const LAS bf16* vb = Vs + (16 * w + 4 * quad + (fr >> 2)) * KSTR + 4 * (fr & 3);
    s16x4 vlo[5][4], vhi[5][4];
#pragma unroll
    for (int i = 0; i < 5; ++i)
#pragma unroll
        for (int db = 0; db < 4; ++db) { vlo[i][db] = __builtin_amdgcn_ds_read_tr16_b64_v4i16((LAS s16x4*)(vb + 32 * i * KSTR + 16 * db));
            vhi[i][db] = __builtin_amdgcn_ds_read_tr16_b64_v4i16((LAS s16x4*)(vb + (32 * i + (i < 4 ? 16 : 0)) * KSTR + 16 * db)); }
    const int d = 4 * quad - fr;
#pragma unroll
    for (int j = 0; j < 4; ++j) { if (j + d < 0) st[0][j] = -INFINITY; if (j + d > 0) st[8][j] = -INFINITY; }
#pragma unroll
    for (int T = 0; T < 9; ++T)
#pragma unroll
        for (int j = 0; j < 4; ++j) st[T][j] = __builtin_amdgcn_exp2f(st[T][j]);
    f32x4 lacc = {0.f, 0.f, 0.f, 0.f};
    const bf16x8 ones = {(short)0x3F80, (short)0x3F80, (short)0x3F80, (short)0x3F80, (short)0x3F80, (short)0x3F80, (short)0x3F80, (short)0x3F80};
    f32x4 o[4];
#pragma unroll
    for (int db = 0; db < 4; ++db) o[db] = (f32x4){0.f, 0.f, 0.f, 0.f};
    LDS_WAIT();
#pragma unroll
    for (int i = 0; i < 5; ++i) {
        u32x4 pw; pw.x = pk2(st[2 * i][0], st[2 * i][1]); pw.y = pk2(st[2 * i][2], st[2 * i][3]); pw.z = pk2(st[2 * i + 1][0], st[2 * i + 1][1]); pw.w = pk2(st[2 * i + 1][2], st[2 * i + 1][3]);
        const bf16x8 pb = __builtin_bit_cast(bf16x8, pw);
        lacc = MFMA16(ones, pb, lacc);
#pragma unroll
        for (int db = 0; db < 4; ++db) { const bf16x8 vf = __builtin_shufflevector(vlo[i][db], vhi[i][db], 0, 1, 2, 3, 4, 5, 6, 7); o[db] = MFMA16(vf, pb, o[db]); }
    }
    const float l = lacc[0];
    const float linv = __builtin_amdgcn_rcpf(l);
    const float lse = __builtin_amdgcn_logf(l);
    float* LSE = (float*)(lws(P) + WS_LSE); bf16* OP = (bf16*)(lws(P) + WS_OP);
    if (MODE == 0) {
        bf16* dst = OP + (size_t)u.pat * NT_ * 512 + tq * 512 + u.h * 64 + 4 * quad;
#pragma unroll
        for (int db = 0; db < 4; ++db) { u32x2 wv; wv.x = pk2(o[db][0] * linv, o[db][1] * linv); wv.y = pk2(o[db][2] * linv, o[db][3] * linv); *(u32x2*)(dst + 16 * db) = wv; }
        if (quad == 0) LSE[(size_t)u.pat * NT_ * 8 + tq * 8 + u.h] = lse;
    } else {
        const float l0 = aq.l0, l1 = aq.l1;
        const float M = fmaxf(fmaxf(l0, l1), lse);
        const float w0 = __builtin_amdgcn_exp2f(l0 - M), w1 = __builtin_amdgcn_exp2f(l1 - M), w2 = __builtin_amdgcn_exp2f(lse - M);
        const float inv = __builtin_amdgcn_rcpf(w0 + w1 + w2); const float a0 = w0 * inv, a1 = w1 * inv, a2 = w2 * inv * linv;
        bf16* dst = (bf16*)(lws(P) + WS_AO) + tq * 1024 + u.h * 64 + 4 * quad;
#pragma unroll
        for (int db = 0; db < 4; ++db) { const u32x2 x0 = aq.x0[db], x1 = aq.x1[db];
            const float r0 = a0 * bflo(x0.x) + a1 * bflo(x1.x) + a2 * o[db][0], r1 = a0 * bfhi(x0.x) + a1 * bfhi(x1.x) + a2 * o[db][1];
            const float r2 = a0 * bflo(x0.y) + a1 * bflo(x1.y) + a2 * o[db][2], r3 = a0 * bfhi(x0.y) + a1 * bfhi(x1.y) + a2 * o[db][3];
            u32x2 wv; wv.x = pk2(r0, r1); wv.y = pk2(r2, r3); *(u32x2*)(dst + 16 * db) = wv; }
    }
}
DI AU attn_decode_a(int u) { const int xcd = u & 7, lu = u >> 3, bh = xcd * 8 + (lu >> 6), w = lu & 63; AU a; a.b = bh >> 3; a.h = bh & 7;
    if (w < 32) { a.dd = 1; a.r = 0; a.n = w; a.pat = 0; } else { const int w2 = w - 32; a.dd = 4; a.r = w2 >> 3; a.n = w2 & 7; a.pat = 1; } return a; }
DI AU attn_decode_b(int u) { const int xcd = u & 7, lu = u >> 3, bh = xcd * 8 + (lu >> 5), w = lu & 31; AU a; a.b = bh >> 3; a.h = bh & 7; a.dd = 16; a.r = w >> 1; a.n = w & 1; a.pat = 2; return a; }
template <int MODE> DI void attn_run(const Params& P, LAS unsigned char* lds, int nunits) {
    const int tid = ltid(); const int G = gridDim.x;
    int u = lbid(); if (u >= nunits) return;
    u32x4 kv[4], vv[4]; AQ pf;
    AU cur = MODE ? attn_decode_b(u) : attn_decode_a(u);
    attn_load<MODE>(P, cur, tid, kv, vv, pf); attn_stage(lds, tid, kv, vv); __syncthreads();
    for (;;) { const int un = u + G; const bool has_next = un < nunits; AU nxt = cur; const AQ aq = pf;
        if (has_next) { nxt = MODE ? attn_decode_b(un) : attn_decode_a(un); attn_load<MODE>(P, nxt, tid, kv, vv, pf); }
        attn_compute<MODE>(P, lds, cur, tid, aq);
        __syncthreads();
        if (!has_next) break;
        attn_stage(lds, tid, kv, vv); __syncthreads();
        cur = nxt; u = un; }
}

DI void acc8(float (&s)[8], const u32x4& v, float m) { s[0] += m * bflo(v.x); s[1] += m * bfhi(v.x); s[2] += m * bflo(v.y); s[3] += m * bfhi(v.y); s[4] += m * bflo(v.z); s[5] += m * bfhi(v.z); s[6] += m * bflo(v.w); s[7] += m * bfhi(v.w); }
template <int WLEN> DI void pool_unit(const Params& P, int tile64, int g) {
    const int lane = ltid() & 63, fr = lane & 15, quad = lane >> 4;
    const bf16* PB = (const bf16*)(lws(P) + WS_QKVP) + (size_t)96 * 1048576 / 2; const bf16* PWt = (const bf16*)(lws(P) + WS_PW) + g * 128 * 128;
    const float* scale = P.in[11] + 128 * g; bf16* AO = (bf16*)(lws(P) + WS_AO);
    const int t0 = tile64 * 64, tb = t0 + 4 * fr, pos0 = tb & (SEQ - 1);
    bf16x8 pb[4][4];
#pragma unroll
    for (int ks = 0; ks < 4; ++ks) { const bf16* src = PB + (size_t)tb * 512 + 128 * g + 32 * ks + 8 * quad;
        u32x4 row[WLEN + 3];
#pragma unroll
        for (int i = 0; i < WLEN + 3; ++i) { const int o = 3 - i; row[i] = *(const u32x4*)(src + (long)((pos0 + o >= 0) ? o : -pos0) * 512); }
        float sum[8];
#pragma unroll
        for (int j = 0; j < 8; ++j) sum[j] = 0.f;
#pragma unroll
        for (int j = 0; j < WLEN; ++j) acc8(sum, row[3 + j], (pos0 - j >= 0) ? 1.0f : 0.0f);
#pragma unroll
        for (int st = 0; st < 4; ++st) {
            if (st > 0) { acc8(sum, row[3 - st], 1.0f); acc8(sum, row[3 - st + WLEN], (pos0 + st - WLEN >= 0) ? -1.0f : 0.0f); }
            const int tpos = pos0 + st; const int cnt = (tpos + 1 < WLEN) ? tpos + 1 : WLEN; const float rc = 1.0f / (float)cnt;
            const u32x4 own = row[3 - st];
            u32x4 pw; pw.x = pk2(sum[0] * rc - bflo(own.x), sum[1] * rc - bfhi(own.x)); pw.y = pk2(sum[2] * rc - bflo(own.y), sum[3] * rc - bfhi(own.y));
            pw.z = pk2(sum[4] * rc - bflo(own.z), sum[5] * rc - bfhi(own.z)); pw.w = pk2(sum[6] * rc - bflo(own.w), sum[7] * rc - bfhi(own.w));
            pb[st][ks] = __builtin_bit_cast(bf16x8, pw); } }
#pragma unroll
    for (int eb = 0; eb < 8; ++eb) { bf16x8 wf[4];
#pragma unroll
        for (int ks = 0; ks < 4; ++ks) wf[ks] = *(const bf16x8*)(PWt + (16 * eb + fr) * 128 + 32 * ks + 8 * quad);
        const f32x4 sc = *(const f32x4*)(scale + 16 * eb + 4 * quad);
#pragma unroll
        for (int st = 0; st < 4; ++st) { f32x4 a = {0.f, 0.f, 0.f, 0.f};
#pragma unroll
            for (int ks = 0; ks < 4; ++ks) a = MFMA16(wf[ks], pb[st][ks], a);
            a = a * sc; u32x2 wv; wv.x = pk2(a[0], a[1]); wv.y = pk2(a[2], a[3]);
            *(u32x2*)(AO + (size_t)(tb + st) * 1024 + 512 + 128 * g + 16 * eb + 4 * quad) = wv; } }
}

DI void attn_phase_a(const Params& P, LAS unsigned char* lds) { attn_run<0>(P, lds, 4096); }
DI void attn_phase_b(const Params& P, LAS unsigned char* lds) {
    attn_run<1>(P, lds, 2048);
    const int wave = __builtin_amdgcn_readfirstlane(ltid() >> 6);
    for (int id = lbid() * 8 + wave; id < 2048; id += gridDim.x * 8) { const int g = (wave & 4) ? 3 - (id & 3) : (id & 3), tl = id >> 2;
        if (g == 0) pool_unit<2>(P, tl, 0); else if (g == 1) pool_unit<4>(P, tl, 1); else if (g == 2) pool_unit<8>(P, tl, 2); else pool_unit<16>(P, tl, 3); }
}

DI void norm_load(const bf16* XB, const float* SS, int it, int tsub, int c8, u32x4 (&v)[4], f32x4 (&pv)[4]) {
    const int R = it >> 4, gb = it & 15;
#pragma unroll
    for (int i = 0; i < 4; ++i) { const size_t t = (size_t)R * 32 + 8 * i + tsub; v[i] = *(const u32x4*)(XB + t * DM + 64 * gb + 8 * c8); pv[i] = *(const f32x4*)(SS + t * 32 + 4 * c8); }
}
DI void norm_proc(bf16* UG, int it, int tsub, int c8, const u32x4 (&v)[4], const f32x4 (&pv)[4]) {
    const int R = it >> 4, gb = it & 15, g = 4 * gb + (c8 >> 1);
#pragma unroll
    for (int i = 0; i < 4; ++i) { float sm = (pv[i][0] + pv[i][1]) + (pv[i][2] + pv[i][3]); sm += __shfl_xor(sm, 1); sm += __shfl_xor(sm, 2); sm += __shfl_xor(sm, 4);
        const float rs = __builtin_amdgcn_rsqf(sm * (1.0f / 1024.0f) + 1e-6f); u32x4 o;
        o.x = pk2(bflo(v[i].x) * rs, bfhi(v[i].x) * rs); o.y = pk2(bflo(v[i].y) * rs, bfhi(v[i].y) * rs); o.z = pk2(bflo(v[i].z) * rs, bfhi(v[i].z) * rs); o.w = pk2(bflo(v[i].w) * rs, bfhi(v[i].w) * rs);
        *(u32x4*)(UG + ((size_t)g * 1024 + R) * 640 + (8 * i + tsub) * 16 + 8 * (c8 & 1)) = o; }
}
DI void norm_phase(const Params& P) {
    const int lane = ltid() & 63, wave = __builtin_amdgcn_readfirstlane(ltid() >> 6);
    const bf16* XB = (const bf16*)(lws(P) + WS_XB); const float* SS = (const float*)(lws(P) + WS_SS); bf16* UG = (bf16*)(lws(P) + WS_UG);
    const int tsub = lane >> 3, c8 = lane & 7; const int NGW = gridDim.x * 8; constexpr int NIT = 16384;
    u32x4 va[4], vn[4]; f32x4 pa[4], pn[4];
    int it = lbid() * 8 + wave;
    if (it < NIT) norm_load(XB, SS, it, tsub, c8, va, pa);
    for (; it < NIT; it += NGW) { const int itn = it + NGW; const bool hn = itn < NIT;
        if (hn) norm_load(XB, SS, itn, tsub, c8, vn, pn);
        norm_proc(UG, it, tsub, c8, va, pa);
#pragma unroll
        for (int i = 0; i < 4; ++i) { va[i] = vn[i]; pa[i] = pn[i]; } }
}
DI float gelu_tanh(float x) { const float z = 1.5957691216057308f * (x + 0.044715f * x * x * x); return x * __builtin_amdgcn_rcpf(1.0f + __builtin_amdgcn_exp2f(-1.4426950408889634f * z)); }
constexpr int EP = 132;
__global__ void __launch_bounds__(512, 2) mega(Params P) {
    extern __shared__ __attribute__((aligned(16))) unsigned char lds_raw[];
    LAS unsigned char* lds = (LAS unsigned char*)lds_raw;
    cg::grid_group grid = cg::this_grid();
    volatile LAS unsigned* MISC = (volatile LAS unsigned*)(lds + 135168);
    if (threadIdx.x < 32) MISC[threadIdx.x] = 0u;
    __syncthreads();
    const XcdBarrier bar = xcd_barrier_post((unsigned*)P.ws, MISC + 8);
    if (P.out == nullptr) grid.sync();
    const int G = gridDim.x;
    bf16* XB = (bf16*)(lws(P) + WS_XB); float* SS = (float*)(lws(P) + WS_SS); bf16* ACT = (bf16*)(lws(P) + WS_ACT);
#pragma unroll 1
    for (int pi = 0; pi < NPROG; ++pi) {
        const int step = pi - ((DUP_A >= 0 && pi > DUP_A) ? 1 : 0) - ((DUP_B >= 0 && pi > DUP_B + 1) ? 1 : 0);
        if (step == 0) { if (PHMASK & 1) prologue(P, lds); }
        else if (step == 1 || step == 7 || step == 9 || step == 15) {
            const int ls = (step == 1) ? 0 : (step == 7) ? 1 : (step == 9) ? 2 : 3;
            pg8::Gemm g{XB, (const bf16*)(lws(P) + WS_WGU) + (size_t)ls * 5632 * 1024, NT_, 2 * FF, DM}; pg8::StaticOrder S; S.init(NT_, 2 * FF, G, (int)lbid());
            pg8::EpiSwiGLU E{ACT, SS};
            if (PHMASK & 2) pg8::gemm_phase<pg8::EpiSwiGLU, pg8::StaticOrder, true, true>(lds, g, S, E);
        } else if (step == 2 || step == 6 || step == 8 || step == 10 || step == 16) {
            const int ls = (step == 2) ? 0 : (step == 8) ? 1 : (step == 10) ? 2 : 3;
            const bf16* A = (step == 6) ? (const bf16*)(lws(P) + WS_AO) : ACT;
            const bf16* Bt = (step == 6) ? (const bf16*)(lws(P) + WS_WOUT) : (const bf16*)(lws(P) + WS_WD) + (size_t)ls * 1024 * 2816;
            const int K = (step == 6) ? DM : FF;
            pg8::Gemm g{A, Bt, NT_, DM, K}; pg8::StaticOrder S; S.init(NT_, DM, G, (int)lbid());
            pg8::EpiResid E{(step == 16) ? P.out : (float*)nullptr, XB, SS, (step == 6) ? 1.0f : 0.5f};
            if (PHMASK & 4) pg8::gemm_phase<pg8::EpiResid, pg8::StaticOrder, false, true>(lds, g, S, E);
        } else if (step == 3) {
            pg8::Gemm g{XB, (const bf16*)(lws(P) + WS_WIN), NT_, 2048, DM}; pg8::StaticOrder S; S.init(NT_, 2048, G, (int)lbid());
            pg8::EpiQKVP E{(bf16*)(lws(P) + WS_QKVP), SS, P.in[8], P.in[9], (const float*)(lws(P) + WS_CS), QSCALE};
            if (PHMASK & 8) pg8::gemm_phase<pg8::EpiQKVP, pg8::StaticOrder, true, true>(lds, g, S, E);
        } else if (step == 4) { if (PHMASK & 16) attn_phase_a(P, lds); }
        else if (step == 5) { if (PHMASK & 32) attn_phase_b(P, lds); }
        else if (step == 11) { if (PHMASK & 64) norm_phase(P); }
        else if (step == 12) {
            pg8::Gemm g{(const bf16*)(lws(P) + WS_UG), (const bf16*)(lws(P) + WS_M1), 65536, 256, 512, 640, 512}; pg8::S1Order S; S.G = G; S.c = (int)lbid();
            pg8::EpiS1 E{(bf16*)(lws(P) + WS_UG), (const float*)(lws(P) + WS_A32)};
            if (PHMASK & 128) pg8::gemm_phase<pg8::EpiS1, pg8::S1Order, false, true>(lds, g, S, E);
        }
        else if (step == 13) {
            pg8::Gemm g{(const bf16*)(lws(P) + WS_UG), (const bf16*)(lws(P) + WS_W3), 65536, 512, 640}; pg8::BatchedOrder S; S.G = G; S.c = (int)lbid();
            pg8::EpiS5 E{(bf16*)(lws(P) + WS_Z)};
            if (PHMASK & 128) pg8::gemm_phase<pg8::EpiS5, pg8::BatchedOrder, true, true>(lds, g, S, E);
        }
        else if (step == 14) {
            pg8::Gemm g{(const bf16*)(lws(P) + WS_Z), (const bf16*)(lws(P) + WS_WGLU), NT_, 2048, DM}; pg8::StaticOrder S; S.init(NT_, 2048, G, (int)lbid());
            pg8::EpiGLU E{XB, SS};
            if (PHMASK & 256) pg8::gemm_phase<pg8::EpiGLU, pg8::StaticOrder, true, true>(lds, g, S, E);
        }
        if (pi != NPROG - 1) xcd_barrier(bar);
#ifdef EXTRA_SYNC
        if (pi < 8) xcd_barrier(bar);
#endif
    }
}

extern "C" void kernel_launch(void* const* d_in, const int* in_sizes, int n_in, void* d_out, int out_size, void* d_ws, size_t ws_size, hipStream_t stream) {
    static int grid = 0;
    if (grid == 0) {
        if (n_in != 22 || out_size != NT_ * DM || ws_size < WS_END) { fprintf(stderr, "kernel_launch: unexpected shapes: n_in %d out %d ws %zu\n", n_in, out_size, ws_size); grid = -1; return; }
        int dev = 0, cus = 0, per_cu = 0;
        hipGetDevice(&dev); hipDeviceGetAttribute(&cus, hipDeviceAttributeMultiprocessorCount, dev);
        if (hipFuncSetAttribute((const void*)mega, hipFuncAttributeMaxDynamicSharedMemorySize, LDS_BYTES) != hipSuccess) { fprintf(stderr, "kernel_launch: hipFuncSetAttribute failed\n"); grid = -1; return; }
        if (hipOccupancyMaxActiveBlocksPerMultiprocessor(&per_cu, (const void*)mega, 512, LDS_BYTES) != hipSuccess || per_cu < 1) per_cu = 1;
        (void)hipGetLastError();
        grid = cus * 1;
        (void)per_cu;
    }
    if (grid < 0) return;
    if (hipMemsetAsync(d_ws, 0, 16384, stream) != hipSuccess) { fprintf(stderr, "kernel_launch: memset failed\n"); return; }
    Params p{};
    for (int i = 0; i < 22; ++i) p.in[i] = (const float*)d_in[i];
    p.out = (float*)d_out; p.ws = (unsigned char*)d_ws;
    void* args[] = {&p};
    hipError_t e = hipLaunchCooperativeKernel((const void*)mega, dim3(grid), dim3(512), args, LDS_BYTES, stream);
    if (e != hipSuccess) fprintf(stderr, "cooperative launch failed: %s (grid %d)\n", hipGetErrorString(e), grid);
}
```

```cpp
#include <hip/hip_runtime.h>
#include <hip/hip_cooperative_groups.h>
#include <cstdio>
#include <cstdint>
#include <cmath>
__device__ __forceinline__ int ltid() { int t = threadIdx.x; asm volatile("" : "+v"(t)); return t; }
__device__ __forceinline__ int lbid() { int b = blockIdx.x; asm volatile("" : "+s"(b)); return b; }
namespace pg8 {
#define PG8_LAS __attribute__((address_space(3)))
typedef unsigned short bf16_t;
typedef short bf16x8 __attribute__((ext_vector_type(8)));
typedef float f32x4 __attribute__((ext_vector_type(4)));
typedef unsigned u32x4 __attribute__((ext_vector_type(4)));
constexpr int BM = 256, BK = 64, HALF = 128, HTB = HALF * BK * 2  , STAGE_BYTES = 8 * HTB, NXCD = 8, WGM = 8;

__host__ __device__ __forceinline__ int lds_byte(int r, int c) { const int st = (r >> 4) * 2 + (c >> 5), rr = r & 15, cc = c & 31, ob = rr * 64 + cc * 2; return st * 1024 + (ob ^ (((ob >> 9) & 1) << 5)); }
__host__ __device__ __forceinline__ void stage_rc(int b, int& R, int& C) { const int st = b / 1024, sb = b % 1024, swz = sb ^ (((sb >> 9) & 1) << 5); R = (st >> 1) * 16 + swz / 64; C = (st & 1) * 32 + (swz % 64) / 2; }
__host__ __device__ __forceinline__ int perm32(int rho) { const int n = rho >> 4, i = rho & 15; return 8 * (i >> 2) + 4 * n + (i & 3); }

struct Unit { int pm, pn; };
struct Gemm { const bf16_t* A; const bf16_t* Bt; int M, N, K; int lda = 0, ldb = 0; };

struct StaticOrder {
    int nM, nN, nwg, G, c;
    __host__ __device__ void init(int M, int N, int G_, int c_) { nM = M / BM; nN = N / BM; nwg = nM * nN; G = G_; c = c_; }
    __host__ __device__ bool next(int i, Unit& u) const {
        const long L = (long)i * G + c; if (L >= nwg) return false;
        int wgid = (int)L; { const int q = nwg / NXCD, r = nwg % NXCD, xcd = wgid % NXCD, off = wgid / NXCD; wgid = (xcd < r ? xcd * (q + 1) : r * (q + 1) + (xcd - r) * q) + off; }
        const int nig = WGM * nN, gid = wgid / nig, fm = gid * WGM, gsz = (nM - fm) < WGM ? (nM - fm) : WGM;
        u.pm = fm + ((wgid % nig) % gsz); u.pn = (wgid % nig) / gsz; return true;
    }
    __device__ __forceinline__ void a_ready(const Unit&) const {}
    __device__ __forceinline__ void done(const Unit&) const {}
};

__device__ __forceinline__ unsigned cvt_pk_bf16(float lo, float hi) { unsigned r; asm volatile("v_cvt_pk_bf16_f32 %0, %1, %2" : "=v"(r) : "v"(lo), "v"(hi)); return r; }
typedef float f32x2 __attribute__((ext_vector_type(2)));
typedef unsigned u32x2 __attribute__((ext_vector_type(2)));
__device__ __forceinline__ float fast_exp2(float x) { return __builtin_amdgcn_exp2f(x); }
__device__ __forceinline__ float fast_rcp(float x) { return __builtin_amdgcn_rcpf(x); }
__device__ __forceinline__ float sigmoidf_(float x) { return fast_rcp(1.0f + fast_exp2(-1.4426950408889634f * x)); }
__device__ __forceinline__ float xsum16(float v) { const auto r = __builtin_amdgcn_permlane16_swap(__float_as_uint(v), __float_as_uint(v), false, false); return __uint_as_float(r[0]) + __uint_as_float(r[1]); }
__device__ __forceinline__ float xsum32(float v) { const auto r = __builtin_amdgcn_permlane32_swap(__float_as_uint(v), __float_as_uint(v), false, false); return __uint_as_float(r[0]) + __uint_as_float(r[1]); }
__device__ __forceinline__ float xchg16(float v, int fq) { const auto r = __builtin_amdgcn_permlane16_swap(__float_as_uint(v), __float_as_uint(v), false, false); return (fq & 1) ? __uint_as_float(r[0]) : __uint_as_float(r[1]); }
__device__ __forceinline__ float row_rstd(const float* SS, int row, int fq) {
    const f32x4* q = (const f32x4*)(SS + (size_t)row * 32 + 8 * fq);
    const f32x4 a = q[0], b = q[1];
    float s = ((a[0] + a[1]) + (a[2] + a[3])) + ((b[0] + b[1]) + (b[2] + b[3]));
    s = xsum16(s); s = xsum32(s);
    return __builtin_amdgcn_rsqf(s * (1.0f / 1024.0f) + 1e-6f);
}
__device__ __forceinline__ float rstd_from(const f32x4& a, const f32x4& b) {
    float s = ((a[0] + a[1]) + (a[2] + a[3])) + ((b[0] + b[1]) + (b[2] + b[3]));
    s = xsum16(s); s = xsum32(s);
    return __builtin_amdgcn_rsqf(s * (1.0f / 1024.0f) + 1e-6f);
}
struct EpiSwiGLU {
    static constexpr bool PERM = true, AFTER_DRAIN = false;
    struct State { float rs[2][4]; int pm; }; static __device__ __forceinline__ void init(State& s) { s.pm = -1; }
    bf16_t* ACT; const float* SS;
    __device__ __forceinline__ void operator()(const f32x4 (&acc)[2][2][4][2], const Unit& u, int wr, int wc, int fr, int fq, State& est) const {
        const int col0 = u.pn * 128 + wc * 32 + 8 * fq;
        if (est.pm != u.pm) {
            f32x4 sa[2][4], sb[2][4];
#pragma unroll
            for (int ai = 0; ai < 2; ++ai)
#pragma unroll
                for (int m = 0; m < 4; ++m) { const f32x4* q = (const f32x4*)(SS + (size_t)(u.pm * BM + ai * HALF + wr * 64 + m * 16 + fr) * 32 + 8 * fq); sa[ai][m] = q[0]; sb[ai][m] = q[1]; }
#pragma unroll
            for (int ai = 0; ai < 2; ++ai)
#pragma unroll
                for (int m = 0; m < 4; ++m) est.rs[ai][m] = rstd_from(sa[ai][m], sb[ai][m]);
            est.pm = u.pm; }
#pragma unroll
        for (int ai = 0; ai < 2; ++ai)
#pragma unroll
            for (int m = 0; m < 4; ++m) {
                const int row = u.pm * BM + ai * HALF + wr * 64 + m * 16 + fr;
                const float rs = est.rs[ai][m], c1 = -1.4426950408889634f * rs, rs2 = rs * rs;
                f32x4 v[2];
#pragma unroll
                for (int n = 0; n < 2; ++n) { const f32x4 a = acc[ai][0][m][n], b = acc[ai][1][m][n]; const f32x4 t = a * c1; f32x4 r;
#pragma unroll
                    for (int j = 0; j < 4; ++j) r[j] = fast_rcp(1.0f + fast_exp2(t[j]));
                    v[n] = (a * b) * (r * rs2); }
                u32x4 w; w.x = cvt_pk_bf16(v[0][0], v[0][1]); w.y = cvt_pk_bf16(v[0][2], v[0][3]); w.z = cvt_pk_bf16(v[1][0], v[1][1]); w.w = cvt_pk_bf16(v[1][2], v[1][3]);
                *(u32x4*)(ACT + (size_t)row * 2816 + col0) = w;
            }
    }
};
struct EpiResid {
    static constexpr bool PERM = false, AFTER_DRAIN = false;
    struct State {}; static __device__ __forceinline__ void init(State&) {}
    float* outf; bf16_t* XB; float* SS; float alpha;
    __device__ __forceinline__ void operator()(const f32x4 (&acc)[2][2][4][2], const Unit& u, int wr, int wc, int fr, int fq, State& est) const {
        const int col0 = u.pn * BM + wc * 32 + 4 * fq;
        u32x2 bq[2][4][2][2];
#pragma unroll
        for (int ai = 0; ai < 2; ++ai)
#pragma unroll
            for (int m = 0; m < 4; ++m) { const size_t off = (size_t)(u.pm * BM + ai * HALF + wr * 64 + m * 16 + fr) * 1024 + col0;
#pragma unroll
                for (int bj = 0; bj < 2; ++bj)
#pragma unroll
                    for (int n = 0; n < 2; ++n) bq[ai][m][bj][n] = *(const u32x2*)(XB + off + bj * HALF + n * 16); }
#pragma unroll
        for (int ai = 0; ai < 2; ++ai) {
#pragma unroll
            for (int m = 0; m < 4; ++m) {
                const int row = u.pm * BM + ai * HALF + wr * 64 + m * 16 + fr;
                const size_t off = (size_t)row * 1024 + col0;
#pragma unroll
                for (int bj = 0; bj < 2; ++bj) {
                    float ss = 0.f;
#pragma unroll
                    for (int n = 0; n < 2; ++n) {
                        const u32x2 bb = bq[ai][m][bj][n];
                        f32x4 o; o[0] = __uint_as_float(bb.x << 16) + acc[ai][bj][m][n][0] * alpha; o[1] = __uint_as_float(bb.x & 0xffff0000u) + acc[ai][bj][m][n][1] * alpha;
                        o[2] = __uint_as_float(bb.y << 16) + acc[ai][bj][m][n][2] * alpha; o[3] = __uint_as_float(bb.y & 0xffff0000u) + acc[ai][bj][m][n][3] * alpha;
                        if (outf) { __builtin_nontemporal_store(o, (f32x4*)(outf + off + bj * HALF + n * 16)); continue; }
                        u32x2 w; w.x = cvt_pk_bf16(o[0], o[1]); w.y = cvt_pk_bf16(o[2], o[3]);
                        *(u32x2*)(XB + off + bj * HALF + n * 16) = w;
                        ss += (o[0] * o[0] + o[1] * o[1]) + (o[2] * o[2] + o[3] * o[3]);
                    }
                    if (outf) continue;
                    ss = xsum16(ss); ss = xsum32(ss);
                    if (fq == 0) SS[(size_t)row * 32 + 8 * u.pn + 4 * bj + wc] = ss;
                }
            }
        }
    }
};
struct EpiGLU {
    static constexpr bool PERM = false, AFTER_DRAIN = false;
    struct State {}; static __device__ __forceinline__ void init(State&) {}
    bf16_t* XB; float* SS;
    __device__ __forceinline__ void operator()(const f32x4 (&acc)[2][2][4][2], const Unit& u, int wr, int wc, int fr, int fq, State& est) const {
        const int col0 = u.pn * 128 + wc * 32 + 4 * fq;
        u32x2 bq[2][4][2];
#pragma unroll
        for (int ai = 0; ai < 2; ++ai)
#pragma unroll
            for (int m = 0; m < 4; ++m) { const size_t off = (size_t)(u.pm * BM + ai * HALF + wr * 64 + m * 16 + fr) * 1024 + col0;
#pragma unroll
                for (int n = 0; n < 2; ++n) bq[ai][m][n] = *(const u32x2*)(XB + off + n * 16); }
#pragma unroll
        for (int ai = 0; ai < 2; ++ai) {
#pragma unroll
            for (int m = 0; m < 4; ++m) {
                const int row = u.pm * BM + ai * HALF + wr * 64 + m * 16 + fr;
                const size_t off = (size_t)row * 1024 + col0;
                float ss = 0.f;
#pragma unroll
                for (int n = 0; n < 2; ++n) {
                    const u32x2 bb = bq[ai][m][n]; const f32x4 tt = acc[ai][1][m][n] * (-1.4426950408889634f); f32x4 r, bv;
#pragma unroll
                    for (int j = 0; j < 4; ++j) r[j] = fast_rcp(1.0f + fast_exp2(tt[j]));
                    bv[0] = __uint_as_float(bb.x << 16); bv[1] = __uint_as_float(bb.x & 0xffff0000u); bv[2] = __uint_as_float(bb.y << 16); bv[3] = __uint_as_float(bb.y & 0xffff0000u);
                    const f32x4 o = bv + acc[ai][0][m][n] * r;
                    u32x2 w; w.x = cvt_pk_bf16(o[0], o[1]); w.y = cvt_pk_bf16(o[2], o[3]);
                    *(u32x2*)(XB + off + n * 16) = w;
                    ss += (o[0] * o[0] + o[1] * o[1]) + (o[2] * o[2] + o[3] * o[3]);
                }
                ss = xsum16(ss); ss = xsum32(ss);
                if (fq == 0) SS[(size_t)row * 32 + 4 * u.pn + wc] = ss;
            }
        }
    }
};
struct EpiQKVP {
    static constexpr bool PERM = true, AFTER_DRAIN = false;
    struct State { float r0, r1, r2, r3, r4, r5, r6, r7; int pm; }; static __device__ __forceinline__ void init(State& s) { s.pm = -1; }
    bf16_t* O; const float* SS; const float* qn; const float* kn; const float* CS; float qscale;
    __device__ __forceinline__ void operator()(const f32x4 (&acc)[2][2][4][2], const Unit& u, int wr, int wc, int fr, int fq, State& est) const {
        const int kind = u.pn >> 1;
        const int cb = u.pn * BM + wc * 64 + 8 * fq;
        const float* gsrc = (kind == 0) ? qn : kn;
        f32x4 gv[2][2];
#pragma unroll
        for (int bj = 0; bj < 2; ++bj)
#pragma unroll
            for (int n = 0; n < 2; ++n) gv[bj][n] = *(const f32x4*)(gsrc + 32 * bj + 8 * fq + 4 * n);
        if (est.pm != u.pm) {
            float t[2][4];
#pragma unroll
            for (int ai = 0; ai < 2; ++ai) { f32x4 sa[4], sb[4];
#pragma unroll
                for (int m = 0; m < 4; ++m) { const f32x4* q = (const f32x4*)(SS + (size_t)(u.pm * BM + ai * HALF + wr * 64 + m * 16 + fr) * 32 + 8 * fq); sa[m] = q[0]; sb[m] = q[1]; }
#pragma unroll
                for (int m = 0; m < 4; ++m) t[ai][m] = rstd_from(sa[m], sb[m]); }
            est.r0 = t[0][0]; est.r1 = t[0][1]; est.r2 = t[0][2]; est.r3 = t[0][3]; est.r4 = t[1][0]; est.r5 = t[1][1]; est.r6 = t[1][2]; est.r7 = t[1][3]; est.pm = u.pm; }
        const float rsv[2][4] = {{est.r0, est.r1, est.r2, est.r3}, {est.r4, est.r5, est.r6, est.r7}};
#pragma unroll
        for (int aim = 0; aim < 4; ++aim) { const int ai = aim >> 1, mp = aim & 1;
            f32x4 csv[2][2], snv[2][2];
#pragma unroll
            for (int mm = 0; mm < 2; ++mm) { const size_t row = (size_t)(u.pm * BM + ai * HALF + wr * 64 + (2 * mp + mm) * 16 + fr);
#pragma unroll
                for (int n = 0; n < 2; ++n) { const f32x4 lc = *(const f32x4*)(CS + row * 16 + 4 * n), ls = *(const f32x4*)(CS + row * 16 + 8 + 4 * n);
#pragma unroll
                    for (int j = 0; j < 4; ++j) { csv[mm][n][j] = (kind < 2) ? lc[j] : 1.0f; snv[mm][n][j] = (kind < 2) ? ls[j] : 0.0f; } } }
#pragma unroll
            for (int mm = 0; mm < 2; ++mm) { const int m = 2 * mp + mm;
                const int row = u.pm * BM + ai * HALF + wr * 64 + m * 16 + fr;
                const float rs = rsv[ai][m];
                f32x4 v[2][2];
#pragma unroll
                for (int bj = 0; bj < 2; ++bj)
#pragma unroll
                    for (int n = 0; n < 2; ++n) v[bj][n] = acc[ai][bj][m][n] * rs;
                if (kind < 2) {
                    float ss = 0.f;
#pragma unroll
                    for (int bj = 0; bj < 2; ++bj)
#pragma unroll
                        for (int n = 0; n < 2; ++n) ss += (v[bj][n][0] * v[bj][n][0] + v[bj][n][1] * v[bj][n][1]) + (v[bj][n][2] * v[bj][n][2] + v[bj][n][3] * v[bj][n][3]);
                    ss = xsum16(ss); ss = xsum32(ss);
                    const float hn = __builtin_amdgcn_rsqf(ss * (1.0f / 64.0f) + 1e-6f);
#pragma unroll
                    for (int bj = 0; bj < 2; ++bj)
#pragma unroll
                        for (int n = 0; n < 2; ++n) v[bj][n] = v[bj][n] * hn * gv[bj][n];
#pragma unroll
                    for (int n = 0; n < 2; ++n) {
                        const f32x4 cs = csv[mm][n], sn = snv[mm][n];
                        f32x4 mine = v[0][n], other;
#pragma unroll
                        for (int j = 0; j < 4; ++j) other[j] = xchg16(mine[j], fq);
                        if (fq == 0) v[0][n] = mine * cs - other * sn;
                        else if (fq == 1) v[0][n] = mine * cs + other * sn;
                    }
                    if (kind == 0) {
#pragma unroll
                        for (int bj = 0; bj < 2; ++bj)
#pragma unroll
                            for (int n = 0; n < 2; ++n) v[bj][n] = v[bj][n] * qscale;
                    }
                }
#pragma unroll
                for (int bj = 0; bj < 2; ++bj) {
                    u32x4 w; w.x = cvt_pk_bf16(v[bj][0][0], v[bj][0][1]); w.y = cvt_pk_bf16(v[bj][0][2], v[bj][0][3]); w.z = cvt_pk_bf16(v[bj][1][0], v[bj][1][1]); w.w = cvt_pk_bf16(v[bj][1][2], v[bj][1][3]);
                    if (kind < 3) *(u32x4*)(O + ((size_t)((kind * 8 + (row >> 12)) * 8 + (u.pn & 1) * 4 + wc) * 4096 + (row & 4095)) * 64 + 32 * bj + 8 * fq) = w;
                    else *(u32x4*)(O + (size_t)96 * 1048576 / 2 + (size_t)row * 512 + (u.pn & 1) * 256 + wc * 64 + 32 * bj + 8 * fq) = w;
                }
            }
        }
    }
};

struct BatchedOrder {
    int G, c;
    __device__ __forceinline__ bool next(int i, Unit& u) const { const int L = i * G + c; if (L >= 512) return false; const int xcd = L & 7, q = L >> 3, g = xcd * 8 + (q >> 3), r = q & 7; u.pm = 4 * g + (r & 3); u.pn = 2 * g + (r >> 2); return true; }
    __device__ __forceinline__ void a_ready(const Unit&) const {}
    __device__ __forceinline__ void done(const Unit&) const {}
};
__device__ __forceinline__ float gelu_tanh_(float x) { const float z = 1.5957691216057308f * (x + 0.044715f * x * x * x); return x * fast_rcp(1.0f + fast_exp2(-1.4426950408889634f * z)); }
struct EpiS5 {
    static constexpr bool PERM = true, AFTER_DRAIN = false;
    struct State {}; static __device__ __forceinline__ void init(State&) {}
    bf16_t* Z;
    __device__ __forceinline__ void operator()(const f32x4 (&acc)[2][2][4][2], const Unit& u, int wr, int wc, int fr, int fq, State& est) const {
        const int g = u.pm >> 2;
#pragma unroll
        for (int ai = 0; ai < 2; ++ai)
#pragma unroll
            for (int m = 0; m < 4; ++m) {
                const int rr = (u.pm & 3) * BM + ai * HALF + wr * 64 + m * 16 + fr;
#pragma unroll
                for (int bj = 0; bj < 2; ++bj) {
                    const int t = 16 * (u.pn & 1) + 8 * bj + 2 * wc + (fq >> 1);
                    f32x4 v[2];
#pragma unroll
                    for (int n = 0; n < 2; ++n) { const f32x4 x = acc[ai][bj][m][n]; const f32x4 tt = x * ((x * x) * (-0.10294324f) + (-2.3022082f)); f32x4 r;
#pragma unroll
                        for (int j = 0; j < 4; ++j) r[j] = fast_rcp(1.0f + fast_exp2(tt[j]));
                        v[n] = x * r; }
                    u32x4 w; w.x = cvt_pk_bf16(v[0][0], v[0][1]); w.y = cvt_pk_bf16(v[0][2], v[0][3]); w.z = cvt_pk_bf16(v[1][0], v[1][1]); w.w = cvt_pk_bf16(v[1][2], v[1][3]);
                    *(u32x4*)(Z + ((size_t)rr * 32 + t) * 1024 + 16 * g + 8 * (fq & 1)) = w;
                }
            }
    }
};

struct S1Order {
    int G, c;
    __device__ __forceinline__ bool next(int i, Unit& u) const { const int L = i * G + c; if (L >= 256) return false; const int xcd = L & 7, q = L >> 3, g = xcd * 8 + (q >> 2); u.pm = 4 * g + (q & 3); u.pn = g; return true; }
    __device__ __forceinline__ void a_ready(const Unit&) const {}
    __device__ __forceinline__ void done(const Unit&) const {}
};
struct EpiS1 {
    static constexpr bool PERM = false, AFTER_DRAIN = true;
    struct State {}; static __device__ __forceinline__ void init(State&) {}
    bf16_t* UG; const float* A32;
    __device__ __forceinline__ void fused(f32x4 (&acc)[2][2][4][2], const Unit& u, int wr, int wc, int fr, int fq, PG8_LAS unsigned char* lds, int wid, int lane) const {
        PG8_LAS float* E = (PG8_LAS float*)lds;
        PG8_LAS f32x2* ENDS = (PG8_LAS f32x2*)(lds + 131072);
        const int g = u.pn;
#pragma unroll
        for (int ai = 0; ai < 2; ++ai)
#pragma unroll
            for (int m = 0; m < 4; ++m) { const int r = ai * HALF + wr * 64 + m * 16 + fr;
#pragma unroll
                for (int n = 0; n < 2; ++n) *(PG8_LAS f32x4*)(E + r * 128 + ((wc * 32 + 16 * n + 4 * fq) ^ ((r & 7) << 2))) = acc[ai][0][m][n]; }
        asm volatile("s_waitcnt lgkmcnt(0)" ::: "memory"); __builtin_amdgcn_s_barrier(); asm volatile("" ::: "memory");
        const int bb = wid >> 2, seg = wid & 3, p = lane;
        const float ar = A32[(g * 64 + p) * 2], ai_ = A32[(g * 64 + p) * 2 + 1];
        float lr[32], li[32]; float hr = 0.f, hi = 0.f;
#pragma unroll
        for (int k = 0; k < 32; ++k) { const int r = 128 * bb + 32 * seg + k; lr[k] = hr; li[k] = hi;
            const float er = E[r * 128 + (p ^ ((r & 7) << 2))], ei = E[r * 128 + ((64 + p) ^ ((r & 7) << 2))];
            const float nr = ar * hr - ai_ * hi + er, ni = ar * hi + ai_ * hr + ei; hr = nr; hi = ni; }
        { f32x2 e; e.x = hr; e.y = hi; ENDS[(bb * 4 + seg) * 64 + p] = e; }
        float br = ar, bi = ai_;
#pragma unroll
        for (int q = 0; q < 5; ++q) { const float tr = br * br - bi * bi, ti = 2.0f * br * bi; br = tr; bi = ti; }
        asm volatile("s_waitcnt lgkmcnt(0)" ::: "memory"); __builtin_amdgcn_s_barrier(); asm volatile("" ::: "memory");
        float cr = 0.f, ci = 0.f;
        for (int jj = 0; jj < seg; ++jj) { const f32x2 e = ENDS[(bb * 4 + jj) * 64 + p]; const float nr = br * cr - bi * ci + e.x, ni = br * ci + bi * cr + e.y; cr = nr; ci = ni; }
        bf16_t* dst0 = UG + ((size_t)g * 1024 + (u.pm & 3) * 256 + 128 * bb + 32 * seg) * 640 + 512 + p;
#pragma unroll
        for (int k = 0; k < 32; ++k) { bf16_t* dst = dst0 + (size_t)k * 640;
            dst[0] = (bf16_t)(cvt_pk_bf16(lr[k] + cr, 0.f) & 0xffffu); dst[64] = (bf16_t)(cvt_pk_bf16(li[k] + ci, 0.f) & 0xffffu);
            const float nr = ar * cr - ai_ * ci, ni = ar * ci + ai_ * cr; cr = nr; ci = ni; }
    }
};
template <class Epi, class Sched, bool ALIGN_EPI = false, bool SP2 = false>
__device__ __forceinline__ void gemm_phase(PG8_LAS unsigned char* lds, const Gemm g, const Sched& S, const Epi& E) {
    const int tid = ltid(), wid = __builtin_amdgcn_readfirstlane(tid >> 6), lane = tid & 63, wr = wid >> 2, wc = wid & 3, fr = lane & 15, fq = lane >> 4;
    const int K = g.K, nt = K / BK, LDA = g.lda ? g.lda : g.K, LDB = g.ldb ? g.ldb : g.K;
    unsigned voffA[2], voffB[2];
#pragma unroll
    for (int i = 0; i < 2; ++i) { int R, C; stage_rc(tid * 16 + i * 8192, R, C); const int Rb = Epi::PERM ? ((R & ~31) + perm32(R & 31)) : R;
        voffA[i] = (unsigned)(R * LDA + C) * 2u; voffB[i] = (unsigned)(Rb * LDB + C) * 2u; }
    const size_t kstep = (size_t)(BK * 2);
    const size_t hstepA = (size_t)HALF * LDA * 2, hstepB = (size_t)HALF * LDB * 2;
    const size_t tstepA = 2 * hstepA, tstepB = 2 * hstepB;
    const unsigned ldsw = (unsigned)wid * 1024u;
    const int aoff = lds_byte(wr * 64 + fr, fq * 8), boff = lds_byte(wc * 32 + fr, fq * 8);
#define PG8_SA(b, h) (((b) * 2 + (h)) * HTB)
#define PG8_SB(b, h) ((4 + (b) * 2 + (h)) * HTB)
#define PG8_STAGE(bufoff, gbase, voff) do { _Pragma("unroll") for (int _i = 0; _i < 2; ++_i) \
        __builtin_amdgcn_global_load_lds((const unsigned*)((const char*)(gbase) + (voff)[_i]), (PG8_LAS unsigned*)(lds + (bufoff) + ldsw + _i * 8192), 16, 0, 0); } while (0)
#define PG8_LDA(dst, b, h) do { _Pragma("unroll") for (int m = 0; m < 4; ++m) _Pragma("unroll") for (int k = 0; k < 2; ++k) dst[m][k] = *(const PG8_LAS bf16x8*)(lds + PG8_SA(b, h) + aoff + m * 2048 + k * 1024); } while (0)
#define PG8_LDB(dst, b, h) do { _Pragma("unroll") for (int n = 0; n < 2; ++n) _Pragma("unroll") for (int k = 0; k < 2; ++k) dst[n][k] = *(const PG8_LAS bf16x8*)(lds + PG8_SB(b, h) + boff + n * 2048 + k * 1024); } while (0)
#define PG8_MMA(ai, bj, At, Bt) do { __builtin_amdgcn_s_setprio(1); _Pragma("unroll") for (int m = 0; m < 4; ++m) _Pragma("unroll") for (int n = 0; n < 2; ++n) _Pragma("unroll") for (int k = 0; k < 2; ++k) \
        acc[ai][bj][m][n] = __builtin_amdgcn_mfma_f32_16x16x32_bf16(Bt[n][k], At[m][k], acc[ai][bj][m][n], 0, 0, 0); __builtin_amdgcn_s_setprio(0); } while (0)
#define PG8_WAIT_V(n) asm volatile("s_waitcnt vmcnt(" #n ")" ::: "memory")
#define PG8_WAIT_L(n) asm volatile("s_waitcnt lgkmcnt(" #n ")" ::: "memory")
#define PG8_BAR __builtin_amdgcn_s_barrier()
#define PG8_SCHED __builtin_amdgcn_sched_barrier(0)
    Unit cur, nxt; int ui = 0;
    if (!S.next(0, cur)) return;
    f32x4 acc[2][2][4][2];
    typename Epi::State est; Epi::init(est);
#pragma unroll
    for (int a = 0; a < 2; ++a)
#pragma unroll
        for (int b = 0; b < 2; ++b)
#pragma unroll
            for (int m = 0; m < 4; ++m)
#pragma unroll
                for (int n = 0; n < 2; ++n) acc[a][b][m][n] = (f32x4){0.f, 0.f, 0.f, 0.f};
    bf16x8 At[4][2], B0[2][2], B1[2][2];
    const char* cA = (const char*)g.A + (size_t)cur.pm * tstepA; const char* cB = (const char*)g.Bt + (size_t)cur.pn * tstepB;
    S.a_ready(cur);
    if constexpr (SP2) {
        PG8_STAGE(PG8_SB(0, 0), cB, voffB); PG8_STAGE(PG8_SB(0, 1), cB + hstepB, voffB); PG8_STAGE(PG8_SA(0, 0), cA, voffA); PG8_STAGE(PG8_SA(0, 1), cA + hstepA, voffA);
        if (wr == 1) PG8_BAR;
        PG8_WAIT_V(2); PG8_BAR;
        PG8_STAGE(PG8_SB(1, 0), cB + kstep, voffB); PG8_STAGE(PG8_SA(1, 0), cA + kstep, voffA); PG8_STAGE(PG8_SB(1, 1), cB + hstepB + kstep, voffB);
        PG8_WAIT_V(6); PG8_BAR;
    } else {
        PG8_STAGE(PG8_SB(0, 0), cB, voffB); PG8_STAGE(PG8_SA(0, 0), cA, voffA); PG8_STAGE(PG8_SB(0, 1), cB + hstepB, voffB); PG8_STAGE(PG8_SA(0, 1), cA + hstepA, voffA);
        if (wr == 1) PG8_BAR;
        PG8_WAIT_V(4); PG8_BAR;
        PG8_STAGE(PG8_SB(1, 0), cB + kstep, voffB); PG8_STAGE(PG8_SA(1, 0), cA + kstep, voffA); PG8_STAGE(PG8_SB(1, 1), cB + hstepB + kstep, voffB);
        PG8_WAIT_V(6); PG8_BAR;
    }
    for (;;) {
        const bool has_next = S.next(ui + 1, nxt);
        const char* nA = has_next ? (const char*)g.A + (size_t)nxt.pm * tstepA : cA; const char* nB = has_next ? (const char*)g.Bt + (size_t)nxt.pn * tstepB : cB;
        for (int t = 0; t < nt; t += 2) {
            const bool last = (t == nt - 2);
            const char* a1 = cA + (size_t)(t + 1) * kstep;
            const char* a2 = last ? nA : cA + (size_t)(t + 2) * kstep; const char* b2 = last ? nB : cB + (size_t)(t + 2) * kstep;
            const char* a3 = a2 + kstep; const char* b3 = b2 + kstep;
            if (last && has_next) S.a_ready(nxt);
            if constexpr (SP2) {
            PG8_LDB(B0, 0, 0); PG8_LDB(B1, 0, 1); PG8_SCHED; PG8_LDA(At, 0, 0); PG8_STAGE(PG8_SA(1, 1), a1 + hstepA, voffA);
            PG8_WAIT_V(8); PG8_WAIT_L(0); PG8_BAR; PG8_MMA(0, 0, At, B0); PG8_MMA(0, 1, At, B1); PG8_BAR; PG8_SCHED;
            PG8_LDA(At, 0, 1); PG8_STAGE(PG8_SB(0, 0), b2, voffB); PG8_STAGE(PG8_SB(0, 1), b2 + hstepB, voffB); PG8_STAGE(PG8_SA(0, 0), a2, voffA);
            PG8_WAIT_V(8); PG8_WAIT_L(0); PG8_BAR; PG8_MMA(1, 0, At, B0); PG8_MMA(1, 1, At, B1); PG8_BAR; PG8_SCHED;
            PG8_LDB(B0, 1, 0); PG8_LDB(B1, 1, 1); PG8_SCHED; PG8_LDA(At, 1, 0); PG8_STAGE(PG8_SA(0, 1), a2 + hstepA, voffA);
            PG8_WAIT_V(8); PG8_WAIT_L(0); PG8_BAR; PG8_MMA(0, 0, At, B0); PG8_MMA(0, 1, At, B1); PG8_BAR; PG8_SCHED;
            PG8_LDA(At, 1, 1); PG8_STAGE(PG8_SB(1, 0), b3, voffB); PG8_STAGE(PG8_SB(1, 1), b3 + hstepB, voffB); PG8_STAGE(PG8_SA(1, 0), a3, voffA);
            PG8_WAIT_V(8); PG8_WAIT_L(0); PG8_BAR; PG8_MMA(1, 0, At, B0); PG8_MMA(1, 1, At, B1); PG8_BAR; PG8_SCHED;
            } else {
            PG8_LDB(B0, 0, 0); PG8_SCHED; PG8_LDA(At, 0, 0); PG8_STAGE(PG8_SA(1, 1), a1 + hstepA, voffA);
            PG8_WAIT_L(8); PG8_BAR; PG8_WAIT_L(0); PG8_MMA(0, 0, At, B0); PG8_BAR; PG8_SCHED;
            PG8_LDB(B1, 0, 1); PG8_STAGE(PG8_SB(0, 0), b2, voffB);
            PG8_BAR; PG8_WAIT_L(0); PG8_MMA(0, 1, At, B1); PG8_BAR;
            PG8_LDA(At, 0, 1); PG8_STAGE(PG8_SA(0, 0), a2, voffA);
            PG8_BAR; PG8_WAIT_L(0); PG8_MMA(1, 0, At, B0); PG8_BAR; PG8_SCHED;
            PG8_STAGE(PG8_SB(0, 1), b2 + hstepB, voffB);
            PG8_WAIT_V(6); PG8_BAR; PG8_MMA(1, 1, At, B1); PG8_BAR;
            PG8_LDB(B0, 1, 0); PG8_SCHED; PG8_LDA(At, 1, 0); PG8_STAGE(PG8_SA(0, 1), a2 + hstepA, voffA);
            PG8_WAIT_L(8); PG8_BAR; PG8_WAIT_L(0); PG8_MMA(0, 0, At, B0); PG8_BAR; PG8_SCHED;
            PG8_LDB(B1, 1, 1); PG8_STAGE(PG8_SB(1, 0), b3, voffB);
            PG8_BAR; PG8_WAIT_L(0); PG8_MMA(0, 1, At, B1); PG8_BAR;
            PG8_LDA(At, 1, 1); PG8_STAGE(PG8_SA(1, 0), a3, voffA);
            PG8_BAR; PG8_WAIT_L(0); PG8_MMA(1, 0, At, B0); PG8_BAR; PG8_SCHED;
            PG8_STAGE(PG8_SB(1, 1), b3 + hstepB, voffB);
            PG8_WAIT_V(6); PG8_BAR; PG8_MMA(1, 1, At, B1); PG8_BAR;
            }
        }
        if constexpr (ALIGN_EPI) { if (wr == 0) PG8_BAR; }
        if constexpr (!Epi::AFTER_DRAIN) { E(acc, cur, wr, wc, fr, fq, est); S.done(cur); }
        if (!has_next) break;
#pragma unroll
        for (int a = 0; a < 2; ++a)
#pragma unroll
            for (int b = 0; b < 2; ++b)
#pragma unroll
                for (int m = 0; m < 4; ++m)
#pragma unroll
                    for (int n = 0; n < 2; ++n) acc[a][b][m][n] = (f32x4){0.f, 0.f, 0.f, 0.f};
        cur = nxt; cA = nA; cB = nB; ++ui;
        if constexpr (ALIGN_EPI) { if (wr == 1) PG8_BAR; }
    }
    PG8_WAIT_V(0);
    if constexpr (!ALIGN_EPI) { if (wr == 0) PG8_BAR; }
    PG8_BAR;
    if constexpr (Epi::AFTER_DRAIN) { E.fused(acc, cur, wr, wc, fr, fq, lds, wid, lane); S.done(cur); }
#undef PG8_SA
#undef PG8_SB
#undef PG8_STAGE
#undef PG8_LDA
#undef PG8_LDB
#undef PG8_MMA
#undef PG8_WAIT_V
#undef PG8_WAIT_L
#undef PG8_BAR
#undef PG8_SCHED
}
}
namespace cg = cooperative_groups;
#define LAS __attribute__((address_space(3)))
typedef unsigned short bf16;
typedef short bf16x8 __attribute__((ext_vector_type(8)));
typedef short s16x4 __attribute__((ext_vector_type(4)));
typedef float f32x4 __attribute__((ext_vector_type(4)));
typedef float f32x2 __attribute__((ext_vector_type(2)));
typedef unsigned u32x4 __attribute__((ext_vector_type(4)));
typedef unsigned u32x2 __attribute__((ext_vector_type(2)));
#define DI __device__ __forceinline__
#define MFMA16(a, b, c) __builtin_amdgcn_mfma_f32_16x16x32_bf16((a), (b), (c), 0, 0, 0)

constexpr int NT_ = 32768, DM = 1024, FF = 2816, SEQ = 4096;
constexpr size_t MiB = 1u << 20;
constexpr size_t WS_WGU = 1 * MiB, WS_WD = 45 * MiB, WS_WIN = 67 * MiB, WS_WOUT = 71 * MiB, WS_WGLU = 73 * MiB, WS_PW = 77 * MiB, WS_M1 = 78 * MiB,
                 WS_W3 = 94 * MiB, WS_A32 = 134 * MiB, WS_CS = 135 * MiB, WS_SS = 137 * MiB, WS_LSE = 141 * MiB, WS_XB = 143 * MiB, WS_ACT = 207 * MiB,
                 WS_OP = 383 * MiB, WS_AO = 447 * MiB, WS_END = 511 * MiB;
constexpr size_t WS_QKVP = WS_ACT, WS_UG = WS_ACT, WS_Z = WS_ACT + 80 * MiB;
constexpr int LDS_BYTES = 139264;
constexpr double INV2PI = 0.15915494309189535;
constexpr float QSCALE = 0.125f * 1.4426950408889634f;

#ifndef DUP_A
#define DUP_A -1
#endif
#ifndef DUP_B
#define DUP_B -1
#endif
constexpr int NPROG = 17 + (DUP_A >= 0 ? 1 : 0) + (DUP_B >= 0 ? 1 : 0);
#ifndef PHMASK
#define PHMASK 511
#endif
struct Params { const float* in[22]; float* out; unsigned char* ws; };
DI unsigned char* lws(const Params& P) { const unsigned long long w = (unsigned long long)P.ws; unsigned lo = __builtin_amdgcn_readfirstlane((unsigned)w), hi = __builtin_amdgcn_readfirstlane((unsigned)(w >> 32)); asm volatile("" : "+s"(lo), "+s"(hi)); return (unsigned char*)(__attribute__((address_space(1))) unsigned char*)(((unsigned long long)hi << 32) | lo); }

DI unsigned pk2(float lo, float hi) { return pg8::cvt_pk_bf16(lo, hi); }
DI float bflo(unsigned u) { return __uint_as_float(u << 16); }
DI float bfhi(unsigned u) { return __uint_as_float(u & 0xffff0000u); }
DI float wave_sum(float v) {
#pragma unroll
    for (int o = 1; o < 64; o <<= 1) v += __shfl_xor(v, o);
    return v;
}
DI void cis_rev(double rev, float& c, float& s) { rev -= __builtin_rint(rev); const float r = (float)rev; c = __builtin_amdgcn_cosf(r); s = __builtin_amdgcn_sinf(r); }
#define LDS_WAIT() asm volatile("s_waitcnt lgkmcnt(0)" ::: "memory")
#define XB_TMO      128
#define XB_XCNT(j)  (256  + 64 * (j))
#define XB_XSUB(j)  (1280 + 64 * (j))
#define XB_XGEN(j)  (2304 + 64 * (j))
#define XB_TOP      3328
#define XB_TOPGEN   3392
#define XCD_BAR_WORDS 3456
#define XB_SPIN_CAP (1u << 18)

__device__ __forceinline__ unsigned xb_ld(unsigned* p)              { return __hip_atomic_load(p, __ATOMIC_RELAXED, __HIP_MEMORY_SCOPE_AGENT); }
__device__ __forceinline__ unsigned xb_add(unsigned* p, unsigned v) { return __hip_atomic_fetch_add(p, v, __ATOMIC_RELAXED, __HIP_MEMORY_SCOPE_AGENT); }
__device__ __forceinline__ unsigned xb_xcc_id() { return (unsigned)__builtin_amdgcn_s_getreg((3 << 11) | 20) & 0xFu; }
#define XB_SPIN(cond, bar) do { unsigned _sp = 0; while (cond) { __builtin_amdgcn_s_sleep(1); \
    if ((++_sp & 255u) == 0u) { if (xb_ld(&(bar)[XB_TMO])) break; if (_sp > XB_SPIN_CAP) { atomicAdd(&(bar)[XB_TMO], 1u); break; } } } } while (0)

struct XcdBarrier {
    unsigned* bar; unsigned x;
    volatile LAS unsigned* st;
};

__device__ __forceinline__ XcdBarrier xcd_barrier_post(unsigned* bar, volatile LAS unsigned* st) {
    XcdBarrier b; b.bar = bar; b.x = xb_xcc_id(); b.st = st;
    if (threadIdx.x == 0) (void)xb_add(&bar[XB_XCNT(b.x)], 1u);
    return b;
}
__device__ __forceinline__ void xcd_barrier_complete(unsigned* bar, unsigned x, unsigned& nloc, unsigned& nx) {
    const unsigned G = gridDim.x * gridDim.y * gridDim.z;
    unsigned sum, cnt, mine, sp = 0u;
    for (;;) {
        sum = 0u; cnt = 0u; mine = 0u;
#pragma unroll
        for (unsigned j = 0; j < 16; ++j) { const unsigned c = xb_ld(&bar[XB_XCNT(j)]); sum += c; cnt += (c > 0u) ? 1u : 0u; mine = (j == x) ? c : mine; }
        if (sum == G) break;
        __builtin_amdgcn_s_sleep(1);
        if ((++sp & 255u) == 0u) { if (xb_ld(&bar[XB_TMO])) break; if (sp > XB_SPIN_CAP) { atomicAdd(&bar[XB_TMO], 1u); break; } }
    }
    nloc = mine > 0u ? mine : 1u; nx = cnt > 0u ? cnt : 1u;
}

__device__ __forceinline__ void xcd_barrier(const XcdBarrier& b) {
    asm volatile("s_waitcnt vmcnt(0)" ::: "memory");
    __syncthreads();
    if (threadIdx.x == 0) {
        unsigned* bar = b.bar;
        __builtin_amdgcn_s_waitcnt(0);
        unsigned nloc = b.st[0], nx = b.st[1];
        if (nloc == 0u) { xcd_barrier_complete(bar, b.x, nloc, nx); b.st[0] = nloc; b.st[1] = nx; }
        const unsigned old = xb_add(&bar[XB_XSUB(b.x)], 1u);
        const unsigned gen = old / nloc;
        if (old + 1u == (gen + 1u) * nloc) {
            __builtin_amdgcn_fence(__ATOMIC_RELEASE, "agent");
            asm volatile("s_waitcnt vmcnt(0)" ::: "memory");
            const unsigned og = xb_add(&bar[XB_TOP], 1u);
            const unsigned tg = og / nx;
            if (og + 1u == (tg + 1u) * nx) xb_add(&bar[XB_TOPGEN], 1u);
            else XB_SPIN(xb_ld(&bar[XB_TOPGEN]) == tg, bar);
            __builtin_amdgcn_fence(__ATOMIC_ACQUIRE, "agent");
            xb_add(&bar[XB_XGEN(b.x)], 1u);
            asm volatile("s_waitcnt vmcnt(0)" ::: "memory");
        } else {
            XB_SPIN(xb_ld(&bar[XB_XGEN(b.x)]) == gen, bar);
            __builtin_amdgcn_fence(__ATOMIC_ACQUIRE, "agent");
            asm volatile("s_waitcnt vmcnt(0)" ::: "memory");
        }
    }
    __syncthreads();
}


struct TI { const float* W; const float* gk; bf16* WT; int K, N, dst_row0, k0, n0; };
DI void tr_decode(const Params& P, int it, TI& t) {
    bf16* WGU = (bf16*)(lws(P) + WS_WGU); bf16* WD = (bf16*)(lws(P) + WS_WD);
    if (it < 16896) { const int mtx = it / 1408, r = it % 1408, ls = mtx / 3, kind = mtx % 3;
        if (kind < 2) { const int kb = r / 88, nb = r % 88, n0 = 32 * nb, pn = n0 >> 7, j = n0 & 127;
            t.W = P.in[3 + kind] + (size_t)ls * 1024 * 2816; t.gk = P.in[2] + ls * 1024; t.WT = WGU + (size_t)ls * 5632 * 1024; t.K = 1024; t.N = 2816; t.dst_row0 = 256 * pn + j + (kind ? 128 : 0); t.k0 = 64 * kb; t.n0 = n0;
        } else { const int kb = r >> 5, nb = r & 31, n0 = 32 * nb;
            t.W = P.in[5] + (size_t)ls * 2816 * 1024; t.gk = nullptr; t.WT = WD + (size_t)ls * 1024 * 2816; t.K = 2816; t.N = 1024; t.dst_row0 = n0; t.k0 = 64 * kb; t.n0 = n0; }
    } else if (it < 16896 + 1024) { const int r = it - 16896, kb = r >> 6, nb = r & 63, n0 = 32 * nb, pn = n0 >> 8, rem = n0 & 255, hh = rem >> 6, bj = (rem & 63) >> 5;
        t.W = P.in[7]; t.gk = P.in[6]; t.WT = (bf16*)(lws(P) + WS_WIN); t.K = 1024; t.N = 2048; t.dst_row0 = 256 * pn + 128 * bj + 32 * hh; t.k0 = 64 * kb; t.n0 = n0;
    } else if (it < 16896 + 1024 + 512) { const int r = it - 17920, kb = r >> 5, nb = r & 31, n0 = 32 * nb;
        t.W = P.in[12]; t.gk = nullptr; t.WT = (bf16*)(lws(P) + WS_WOUT); t.K = 1024; t.N = 1024; t.dst_row0 = n0; t.k0 = 64 * kb; t.n0 = n0;
    } else { const int r = it - 18432, kb = r >> 6, nb = r & 63, n0 = 32 * nb; int dst;
        if (n0 < 1024) dst = 256 * (n0 >> 7) + (n0 & 127); else { const int n1 = n0 - 1024; dst = 256 * (n1 >> 7) + 128 + (n1 & 127); }
        t.W = P.in[21]; t.gk = nullptr; t.WT = (bf16*)(lws(P) + WS_WGLU); t.K = 1024; t.N = 2048; t.dst_row0 = dst; t.k0 = 64 * kb; t.n0 = n0; }
}
DI void tr_load(const TI& t, int lane, float (&v)[32]) {
    const float* src = t.W + (size_t)(t.k0 + (lane >> 5)) * t.N + t.n0 + (lane & 31);
#pragma unroll
    for (int i = 0; i < 32; ++i) v[i] = __builtin_nontemporal_load(src + (size_t)(2 * i) * t.N);
}
DI void tr_proc(const TI& t, LAS float* scr, int lane, const float (&v)[32]) {
#pragma unroll
    for (int i = 0; i < 32; ++i) scr[(2 * i + (lane >> 5)) * 33 + (lane & 31)] = v[i];
    LDS_WAIT(); asm volatile("" ::: "memory");
    const int c = lane & 7;
    f32x4 g0 = {1.f, 1.f, 1.f, 1.f}, g1 = {1.f, 1.f, 1.f, 1.f};
    if (t.gk) { g0 = *(const f32x4*)(t.gk + t.k0 + 8 * c); g1 = *(const f32x4*)(t.gk + t.k0 + 8 * c + 4); }
#pragma unroll
    for (int j = 0; j < 4; ++j) { const int n = (lane >> 3) + 8 * j; const LAS float* s = scr + (8 * c) * 33 + n;
        u32x4 o; o.x = pk2(s[0 * 33] * g0[0], s[1 * 33] * g0[1]); o.y = pk2(s[2 * 33] * g0[2], s[3 * 33] * g0[3]); o.z = pk2(s[4 * 33] * g1[0], s[5 * 33] * g1[1]); o.w = pk2(s[6 * 33] * g1[2], s[7 * 33] * g1[3]);
        *(u32x4*)(t.WT + (size_t)(t.dst_row0 + n) * t.K + t.k0 + 8 * c) = o; }
    LDS_WAIT(); asm volatile("" ::: "memory");
}

DI void s5_gen(const Params& P, LAS unsigned char* lds, int g, int q) {
    LAS f32x2* Pw = (LAS f32x2*)lds;
    LAS f32x2* Bb = Pw + 64 * 33;
    LAS f32x2* Cc = Bb + 1024;
    LAS f32x2* Cf = Cc + 1024;
    LAS float* Kt = (LAS float*)(Cf + 64);
    const int tid = ltid();
    const float* a_re = P.in[13] + g * 64; const float* a_im = P.in[14] + g * 64;
    const float dt = __expf(P.in[15][g]);
    const float* gm = P.in[6] + 1024 + 16 * g;
    const float* b_re = P.in[16] + (size_t)g * 1024; const float* b_im = P.in[17] + (size_t)g * 1024;
    const float* c_re = P.in[18] + (size_t)g * 1024; const float* c_im = P.in[19] + (size_t)g * 1024;
    const float* dsk = P.in[20] + 16 * g;
    float* A32 = (float*)(lws(P) + WS_A32);
    if (tid < 64) {
        const float lr = fminf(a_re[tid], -1e-4f), li = a_im[tid];
        const float mag = __expf(lr * dt); float c, s; cis_rev((double)li * (double)dt * INV2PI, c, s);
        const float lbr = mag * c, lbi = mag * s, den = lr * lr + li * li, nre = lbr - 1.0f;
        f32x2 cf; cf.x = (nre * lr + lbi * li) / den; cf.y = (lbi * lr - nre * li) / den; Cf[tid] = cf;
        const float m32 = __expf(32.0f * lr * dt); cis_rev(32.0 * (double)li * (double)dt * INV2PI, c, s);
        A32[(g * 64 + tid) * 2] = m32 * c; A32[(g * 64 + tid) * 2 + 1] = m32 * s;
    }
    for (int idx = tid; idx < 64 * 33; idx += 512) { const int p_ = idx / 33, n = idx % 33;
        const float lr = fminf(a_re[p_], -1e-4f), li = a_im[p_];
        const float mg = __expf((float)n * lr * dt); float c, s; cis_rev((double)n * (double)li * (double)dt * INV2PI, c, s);
        f32x2 v; v.x = mg * c; v.y = mg * s; Pw[idx] = v; }
    for (int idx = tid; idx < 1024; idx += 512) { f32x2 v; v.x = c_re[idx]; v.y = c_im[idx]; Cc[idx] = v; }
    __syncthreads();
    for (int idx = tid; idx < 1024; idx += 512) { const int p_ = idx >> 4, c_ = idx & 15; const float gg = gm[c_]; const float br = b_re[idx] * gg, bi = b_im[idx] * gg; const f32x2 cf = Cf[p_];
        f32x2 v; v.x = cf.x * br - cf.y * bi; v.y = cf.x * bi + cf.y * br; Bb[idx] = v; }
    __syncthreads();
    { const int pair = tid & 63, cl = pair >> 4, c_ = 4 * q + cl, c2 = pair & 15, tb = tid >> 6; float a[4];
#pragma unroll
      for (int i = 0; i < 4; ++i) a[i] = 0.f;
#pragma unroll 4
      for (int p_ = 0; p_ < 64; ++p_) { const f32x2 C = Cc[c_ * 64 + p_], B = Bb[p_ * 16 + c2]; const float Qx = C.x * B.x - C.y * B.y, Qy = C.x * B.y + C.y * B.x;
#pragma unroll
          for (int i = 0; i < 4; ++i) { const f32x2 L = Pw[p_ * 33 + 4 * tb + i]; a[i] += L.x * Qx - L.y * Qy; } }
      if (tb == 0 && c_ == c2) a[0] += dsk[c_] * gm[c_];
#pragma unroll
      for (int i = 0; i < 4; ++i) Kt[(4 * tb + i) * 64 + pair] = a[i]; }
    __syncthreads();
    bf16* W3 = (bf16*)(lws(P) + WS_W3) + (size_t)g * 512 * 640;
    for (int idx = tid; idx < 128 * 80; idx += 512) { const int nl = idx / 80, kc = idx % 80, t = nl >> 2, cl = nl & 3, c_ = 4 * q + cl, n = t * 16 + c_; float v[8];
        if (kc < 64) { const int s = kc >> 1, c0 = 8 * (kc & 1);
#pragma unroll
            for (int j = 0; j < 8; ++j) v[j] = (s <= t) ? Kt[(t - s) * 64 + cl * 16 + c0 + j] : 0.f;
        } else { const int kk0 = 8 * (kc - 64), ri = kk0 >> 6, p0 = kk0 & 63;
#pragma unroll
            for (int j = 0; j < 8; ++j) { const f32x2 C = Cc[c_ * 64 + p0 + j], L = Pw[(p0 + j) * 33 + t + 1];
                const float Gr = C.x * L.x - C.y * L.y, Gi = C.x * L.y + C.y * L.x; v[j] = ri ? -Gi : Gr; }
        }
        u32x4 o; o.x = pk2(v[0], v[1]); o.y = pk2(v[2], v[3]); o.z = pk2(v[4], v[5]); o.w = pk2(v[6], v[7]);
        *(u32x4*)(W3 + (size_t)n * 640 + kc * 8) = o; }
    bf16* M1 = (bf16*)(lws(P) + WS_M1) + (size_t)g * 256 * 512;
    for (int idx = tid; idx < 32 * 64; idx += 512) { const int n = 32 * q + (idx >> 6), kc = idx & 63, ri = n >> 6, p_ = n & 63, s = kc >> 1, c0 = 8 * (kc & 1); const f32x2 L = Pw[p_ * 33 + 31 - s]; float v[8];
#pragma unroll
        for (int j = 0; j < 8; ++j) { const f32x2 B = Bb[p_ * 16 + c0 + j]; v[j] = ri ? (L.x * B.y + L.y * B.x) : (L.x * B.x - L.y * B.y); }
        u32x4 o; o.x = pk2(v[0], v[1]); o.y = pk2(v[2], v[3]); o.z = pk2(v[4], v[5]); o.w = pk2(v[6], v[7]);
        *(u32x4*)(M1 + (size_t)n * 512 + kc * 8) = o; *(u32x4*)(M1 + (size_t)(128 + n) * 512 + kc * 8) = o; }
    __syncthreads();
}

DI void prologue(const Params& P, LAS unsigned char* lds) {
    const int tid = ltid(), lane = tid & 63, wave = __builtin_amdgcn_readfirstlane(tid >> 6);
    const int G = gridDim.x;
    const bool gen_first = ((lbid() >> 3) & 1) == 0;
    if (gen_first) for (int it = lbid(); it < 256; it += G) s5_gen(P, lds, it >> 2, it & 3);
    LAS float* scr = (LAS float*)(lds + wave * 8448);
    const int gw = lbid() * 8 + wave, NGW = G * 8;
    { constexpr int NIT = 19456; TI ta, tb; float va[32], vb[32]; int it = gw; bool ha = it < NIT;
      if (ha) { tr_decode(P, it, ta); tr_load(ta, lane, va); }
      while (ha) { const int itb = it + NGW; const bool hb = itb < NIT;
          if (hb) { tr_decode(P, itb, tb); tr_load(tb, lane, vb); }
          tr_proc(ta, scr, lane, va);
          if (!hb) break;
          const int ita = itb + NGW; ha = ita < NIT;
          if (ha) { tr_decode(P, ita, ta); tr_load(ta, lane, va); }
          tr_proc(tb, scr, lane, vb);
          it = ita; } }
    { const float* x = P.in[0]; bf16* XB = (bf16*)(lws(P) + WS_XB); float* SS = (float*)(lws(P) + WS_SS);
#define XROW_LOAD(v, m) do { const f32x4* xr_ = (const f32x4*)(x + (size_t)(m) * DM) + lane; _Pragma("unroll") for (int j = 0; j < 4; ++j) v[j] = __builtin_nontemporal_load(xr_ + 64 * j); } while (0)
#define XROW_PROC(v, m) do { unsigned long long* o8_ = (unsigned long long*)(XB + (size_t)(m) * DM) + lane; float s_ = 0.f; \
          _Pragma("unroll") for (int j = 0; j < 4; ++j) { s_ += (v[j][0] * v[j][0] + v[j][1] * v[j][1]) + (v[j][2] * v[j][2] + v[j][3] * v[j][3]); o8_[64 * j] = (unsigned long long)pk2(v[j][0], v[j][1]) | ((unsigned long long)pk2(v[j][2], v[j][3]) << 32); } \
          s_ = wave_sum(s_); if (lane < 32) SS[(size_t)(m) * 32 + lane] = (lane == 0) ? s_ : 0.f; } while (0)
      f32x4 c0[4], c1[4], n0[4], n1[4]; int m = gw;
      if (m < NT_) XROW_LOAD(c0, m); if (m + NGW < NT_) XROW_LOAD(c1, m + NGW);
      for (; m < NT_; m += 2 * NGW) { const int mn = m + 2 * NGW; const bool h2 = mn < NT_, h3 = mn + NGW < NT_;
          if (h2) XROW_LOAD(n0, mn); if (h3) XROW_LOAD(n1, mn + NGW);
          XROW_PROC(c0, m); if (m + NGW < NT_) XROW_PROC(c1, m + NGW);
          _Pragma("unroll") for (int j = 0; j < 4; ++j) { c0[j] = n0[j]; c1[j] = n1[j]; } }
#undef XROW_LOAD
#undef XROW_PROC
    }
    { const int* pos = (const int*)P.in[1]; float* CS = (float*)(lws(P) + WS_CS);
      for (int idx = lbid() * 512 + tid; idx < NT_ * 8; idx += G * 512) { const int t = idx >> 3, i = idx & 7;
          const float inv = exp2f(-(float)(2 * i) * (1.0f / 16.0f) * 18.931568569324174f); const float ang = (float)pos[t] * inv; float c, s; cis_rev((double)ang * INV2PI, c, s);
          CS[(size_t)t * 16 + i] = c; CS[(size_t)t * 16 + 8 + i] = s; } }
    { const float* pw = P.in[10]; bf16* PWt = (bf16*)(lws(P) + WS_PW);
      for (int idx = lbid() * 512 + tid; idx < 4 * 128 * 128; idx += G * 512) { const int g = idx >> 14, e = (idx >> 7) & 127, c = idx & 127;
          PWt[idx] = (bf16)(pk2(pw[(g * 128 + c) * 128 + e], 0.f) & 0xffffu); } }
    if (!gen_first) { __syncthreads(); for (int it = lbid(); it < 256; it += G) s5_gen(P, lds, it >> 2, it & 3); }
}

constexpr int KSTR = 72;
struct AU { int b, h, dd, r, n, pat; };
struct AQ { bf16x8 q[2]; float l0, l1; u32x2 x0[4], x1[4]; };
template <int MODE> DI void attn_load(const Params& P, const AU& u, int tid, u32x4 (&kv)[4], u32x4 (&vv)[4], AQ& aq) {
    const bf16* QKVP = (const bf16*)(lws(P) + WS_QKVP);
    { const int lane = tid & 63, w = tid >> 6, fr = lane & 15, quad = lane >> 4;
      const size_t tq = (size_t)u.b * SEQ + (size_t)(128 * u.n + 16 * w + fr) * u.dd + u.r;
#pragma unroll
      for (int ks = 0; ks < 2; ++ks) aq.q[ks] = *(const bf16x8*)(QKVP + ((size_t)(u.b * 8 + u.h) * 4096 + (size_t)(128 * u.n + 16 * w + fr) * u.dd + u.r) * 64 + 32 * ks + 8 * quad);
      if (MODE == 1) { const float* LSE = (const float*)(lws(P) + WS_LSE); const bf16* OP = (const bf16*)(lws(P) + WS_OP);
          aq.l0 = LSE[tq * 8 + u.h]; aq.l1 = LSE[(size_t)NT_ * 8 + tq * 8 + u.h];
          const bf16* s0 = OP + tq * 512 + u.h * 64 + 4 * quad; const bf16* s1 = s0 + (size_t)NT_ * 512;
#pragma unroll
          for (int db = 0; db < 4; ++db) { aq.x0[db] = *(const u32x2*)(s0 + 16 * db); aq.x1[db] = *(const u32x2*)(s1 + 16 * db); } } }
#pragma unroll
    for (int i = 0; i < 4; ++i) { const int idx = tid + 512 * i, row = idx >> 3, ch = idx & 7, m2 = 128 * u.n - 128 + row;
        kv[i] = (u32x4){0u, 0u, 0u, 0u}; vv[i] = (u32x4){0u, 0u, 0u, 0u};
        if (m2 >= 0) { const size_t tp = (size_t)m2 * u.dd + u.r; const bf16* src = QKVP + ((size_t)((8 + u.b) * 8 + u.h) * 4096 + tp) * 64 + ch * 8; kv[i] = *(const u32x4*)src; vv[i] = *(const u32x4*)(src + (size_t)64 * 4096 * 64); } }
}
DI void attn_stage(LAS unsigned char* lds, int tid, const u32x4 (&kv)[4], const u32x4 (&vv)[4]) {
    LAS bf16* Ks = (LAS bf16*)lds; LAS bf16* Vs = Ks + 256 * KSTR;
#pragma unroll
    for (int i = 0; i < 4; ++i) { const int idx = tid + 512 * i, row = idx >> 3, ch = idx & 7; *(LAS u32x4*)(Ks + row * KSTR + ch * 8) = kv[i]; *(LAS u32x4*)(Vs + row * KSTR + ch * 8) = vv[i]; }
}
template <int MODE> DI void attn_compute(const Params& P, LAS unsigned char* lds, const AU& u, int tid, const AQ& aq) {
    const int lane = tid & 63, w = __builtin_amdgcn_readfirstlane(tid >> 6), fr = lane & 15, quad = lane >> 4;
    LAS bf16* Ks = (LAS bf16*)lds; LAS bf16* Vs = Ks + 256 * KSTR;
    const bf16* QKVP = (const bf16*)(lws(P) + WS_QKVP);
    const size_t tq = (size_t)u.b * SEQ + (size_t)(128 * u.n + 16 * w + fr) * u.dd + u.r;
    bf16x8 qf[2]; qf[0] = aq.q[0]; qf[1] = aq.q[1];
    const LAS bf16* kb = Ks + (16 * w + fr) * KSTR + 8 * quad;
    bf16x8 kf[9][2];
#pragma unroll
    for (int T = 0; T < 9; ++T)
#pragma unroll
        for (int ks = 0; ks < 2; ++ks) kf[T][ks] = *(const LAS bf16x8*)(kb + 16 * T * KSTR + 32 * ks);
    LDS_WAIT();
    f32x4 st[10];
    if (u.n == 0) {
#pragma unroll
        for (int T = 0; T < 9; ++T) { const float bias = (T + w < 8) ? -INFINITY : 0.f;
            f32x4 a = {bias, bias, bias, bias}; a = MFMA16(kf[T][0], qf[0], a); a = MFMA16(kf[T][1], qf[1], a); st[T] = a; }
    } else {
#pragma unroll
        for (int T = 0; T < 9; ++T) { f32x4 a = {0.f, 0.f, 0.f, 0.f}; a = MFMA16(kf[T][0], qf[0], a); a = MFMA16(kf[T][1], qf[1], a); st[T] = a; }
    }
    st[9] = (f32x4){0.f, 0.f, 0.f, 0.f};
    const LAS bf16* vb = Vs + (16 * w + 4 * quad + (fr >> 2)) * KSTR + 4 * (fr & 3);
    s16x4 vlo[5][4], vhi[5][4];
#pragma unroll
    for (int i = 0; i < 5; ++i)
#pragma unroll
        for (int db = 0; db < 4; ++db) { vlo[i][db] = __builtin_amdgcn_ds_read_tr16_b64_v4i16((LAS s16x4*)(vb + 32 * i * KSTR + 16 * db));
            vhi[i][db] = __builtin_amdgcn_ds_read_tr16_b64_v4i16((LAS s16x4*)(vb + (32 * i + (i < 4 ? 16 : 0)) * KSTR + 16 * db)); }
    const int d = 4 * quad - fr;
#pragma unroll
    for (int j = 0; j < 4; ++j) { if (j + d < 0) st[0][j] = -INFINITY; if (j + d > 0) st[8][j] = -INFINITY; }
#pragma unroll
    for (int T = 0; T < 9; ++T)
#pragma unroll
        for (int j = 0; j < 4; ++j) st[T][j] = __builtin_amdgcn_exp2f(st[T][j]);
    f32x4 lacc = {0.f, 0.f, 0.f, 0.f};
    const bf16x8 ones = {(short)0x3F80, (short)0x3F80, (short)0x3F80, (short)0x3F80, (short)0x3F80, (short)0x3F80, (short)0x3F80, (short)0x3F80};
    f32x4 o[4];
#pragma unroll
    for (int db = 0; db < 4; ++db) o[db] = (f32x4){0.f, 0.f, 0.f, 0.f};
    LDS_WAIT();
#pragma unroll
    for (int i = 0; i < 5; ++i) {
        u32x4 pw; pw.x = pk2(st[2 * i][0], st[2 * i][1]); pw.y = pk2(st[2 * i][2], st[2 * i][3]); pw.z = pk2(st[2 * i + 1][0], st[2 * i + 1][1]); pw.w = pk2(st[2 * i + 1][2], st[2 * i + 1][3]);
        const bf16x8 pb = __builtin_bit_cast(bf16x8, pw);
        lacc = MFMA16(ones, pb, lacc);
#pragma unroll
        for (int db = 0; db < 4; ++db) { const bf16x8 vf = __builtin_shufflevector(vlo[i][db], vhi[i][db], 0, 1, 2, 3, 4, 5, 6, 7); o[db] = MFMA16(vf, pb, o[db]); }
    }
    const float l = lacc[0];
    const float linv = __builtin_amdgcn_rcpf(l);
    const float lse = __builtin_amdgcn_logf(l);
    float* LSE = (float*)(lws(P) + WS_LSE); bf16* OP = (bf16*)(lws(P) + WS_OP);
    if (MODE == 0) {
        bf16* dst = OP + (size_t)u.pat * NT_ * 512 + tq * 512 + u.h * 64 + 4 * quad;
#pragma unroll
        for (int db = 0; db < 4; ++db) { u32x2 wv; wv.x = pk2(o[db][0] * linv, o[db][1] * linv); wv.y = pk2(o[db][2] * linv, o[db][3] * linv); *(u32x2*)(dst + 16 * db) = wv; }
        if (quad == 0) LSE[(size_t)u.pat * NT_ * 8 + tq * 8 + u.h] = lse;
    } else {
        const float l0 = aq.l0, l1 = aq.l1;
        const float M = fmaxf(fmaxf(l0, l1), lse);
        const float w0 = __builtin_amdgcn_exp2f(l0 - M), w1 = __builtin_amdgcn_exp2f(l1 - M), w2 = __builtin_amdgcn_exp2f(lse - M);
        const float inv = __builtin_amdgcn_rcpf(w0 + w1 + w2); const float a0 = w0 * inv, a1 = w1 * inv, a2 = w2 * inv * linv;
        bf16* dst = (bf16*)(lws(P) + WS_AO) + tq * 1024 + u.h * 64 + 4 * quad;
#pragma unroll
        for (int db = 0; db < 4; ++db) { const u32x2 x0 = aq.x0[db], x1 = aq.x1[db];
            const float r0 = a0 * bflo(x0.x) + a1 * bflo(x1.x) + a2 * o[db][0], r1 = a0 * bfhi(x0.x) + a1 * bfhi(x1.x) + a2 * o[db][1];
            const float r2 = a0 * bflo(x0.y) + a1 * bflo(x1.y) + a2 * o[db][2], r3 = a0 * bfhi(x0.y) + a1 * bfhi(x1.y) + a2 * o[db][3];
            u32x2 wv; wv.x = pk2(r0, r1); wv.y = pk2(r2, r3); *(u32x2*)(dst + 16 * db) = wv; }
    }
}
DI AU attn_decode_a(int u) { const int xcd = u & 7, lu = u >> 3, bh = xcd * 8 + (lu >> 6), w = lu & 63; AU a; a.b = bh >> 3; a.h = bh & 7;
    if (w < 32) { a.dd = 1; a.r = 0; a.n = w; a.pat = 0; } else { const int w2 = w - 32; a.dd = 4; a.r = w2 >> 3; a.n = w2 & 7; a.pat = 1; } return a; }
DI AU attn_decode_b(int u) { const int xcd = u & 7, lu = u >> 3, bh = xcd * 8 + (lu >> 5), w = lu & 31; AU a; a.b = bh >> 3; a.h = bh & 7; a.dd = 16; a.r = w >> 1; a.n = w & 1; a.pat = 2; return a; }
template <int MODE> DI void attn_run(const Params& P, LAS unsigned char* lds, int nunits) {
    const int tid = ltid(); const int G = gridDim.x;
    int u = lbid(); if (u >= nunits) return;
    u32x4 kv[4], vv[4]; AQ pf;
    AU cur = MODE ? attn_decode_b(u) : attn_decode_a(u);
    attn_load<MODE>(P, cur, tid, kv, vv, pf); attn_stage(lds, tid, kv, vv); __syncthreads();
    for (;;) { const int un = u + G; const bool has_next = un < nunits; AU nxt = cur; const AQ aq = pf;
        if (has_next) { nxt = MODE ? attn_decode_b(un) : attn_decode_a(un); attn_load<MODE>(P, nxt, tid, kv, vv, pf); }
        attn_compute<MODE>(P, lds, cur, tid, aq);
        __syncthreads();
        if (!has_next) break;
        attn_stage(lds, tid, kv, vv); __syncthreads();
        cur = nxt; u = un; }
}

DI void acc8(float (&s)[8], const u32x4& v, float m) { s[0] += m * bflo(v.x); s[1] += m * bfhi(v.x); s[2] += m * bflo(v.y); s[3] += m * bfhi(v.y); s[4] += m * bflo(v.z); s[5] += m * bfhi(v.z); s[6] += m * bflo(v.w); s[7] += m * bfhi(v.w); }
template <int WLEN> DI void pool_unit(const Params& P, int tile64, int g) {
    const int lane = ltid() & 63, fr = lane & 15, quad = lane >> 4;
    const bf16* PB = (const bf16*)(lws(P) + WS_QKVP) + (size_t)96 * 1048576 / 2; const bf16* PWt = (const bf16*)(lws(P) + WS_PW) + g * 128 * 128;
    const float* scale = P.in[11] + 128 * g; bf16* AO = (bf16*)(lws(P) + WS_AO);
    const int t0 = tile64 * 64, tb = t0 + 4 * fr, pos0 = tb & (SEQ - 1);
    bf16x8 pb[4][4];
#pragma unroll
    for (int ks = 0; ks < 4; ++ks) { const bf16* src = PB + (size_t)tb * 512 + 128 * g + 32 * ks + 8 * quad;
        u32x4 row[WLEN + 3];
#pragma unroll
        for (int i = 0; i < WLEN + 3; ++i) { const int o = 3 - i; row[i] = *(const u32x4*)(src + (long)((pos0 + o >= 0) ? o : -pos0) * 512); }
        float sum[8];
#pragma unroll
        for (int j = 0; j < 8; ++j) sum[j] = 0.f;
#pragma unroll
        for (int j = 0; j < WLEN; ++j) acc8(sum, row[3 + j], (pos0 - j >= 0) ? 1.0f : 0.0f);
#pragma unroll
        for (int st = 0; st < 4; ++st) {
            if (st > 0) { acc8(sum, row[3 - st], 1.0f); acc8(sum, row[3 - st + WLEN], (pos0 + st - WLEN >= 0) ? -1.0f : 0.0f); }
            const int tpos = pos0 + st; const int cnt = (tpos + 1 < WLEN) ? tpos + 1 : WLEN; const float rc = 1.0f / (float)cnt;
            const u32x4 own = row[3 - st];
            u32x4 pw; pw.x = pk2(sum[0] * rc - bflo(own.x), sum[1] * rc - bfhi(own.x)); pw.y = pk2(sum[2] * rc - bflo(own.y), sum[3] * rc - bfhi(own.y));
            pw.z = pk2(sum[4] * rc - bflo(own.z), sum[5] * rc - bfhi(own.z)); pw.w = pk2(sum[6] * rc - bflo(own.w), sum[7] * rc - bfhi(own.w));
            pb[st][ks] = __builtin_bit_cast(bf16x8, pw); } }
#pragma unroll
    for (int eb = 0; eb < 8; ++eb) { bf16x8 wf[4];
#pragma unroll
        for (int ks = 0; ks < 4; ++ks) wf[ks] = *(const bf16x8*)(PWt + (16 * eb + fr) * 128 + 32 * ks + 8 * quad);
        const f32x4 sc = *(const f32x4*)(scale + 16 * eb + 4 * quad);
#pragma unroll
        for (int st = 0; st < 4; ++st) { f32x4 a = {0.f, 0.f, 0.f, 0.f};
#pragma unroll
            for (int ks = 0; ks < 4; ++ks) a = MFMA16(wf[ks], pb[st][ks], a);
            a = a * sc; u32x2 wv; wv.x = pk2(a[0], a[1]); wv.y = pk2(a[2], a[3]);
            *(u32x2*)(AO + (size_t)(tb + st) * 1024 + 512 + 128 * g + 16 * eb + 4 * quad) = wv; } }
}

DI void attn_phase_a(const Params& P, LAS unsigned char* lds) { attn_run<0>(P, lds, 4096); }
DI void attn_phase_b(const Params& P, LAS unsigned char* lds) {
    attn_run<1>(P, lds, 2048);
    const int wave = __builtin_amdgcn_readfirstlane(ltid() >> 6);
    for (int id = lbid() * 8 + wave; id < 2048; id += gridDim.x * 8) { const int g = (wave & 4) ? 3 - (id & 3) : (id & 3), tl = id >> 2;
        if (g == 0) pool_unit<2>(P, tl, 0); else if (g == 1) pool_unit<4>(P, tl, 1); else if (g == 2) pool_unit<8>(P, tl, 2); else pool_unit<16>(P, tl, 3); }
}

DI void norm_load(const bf16* XB, const float* SS, int it, int tsub, int c8, u32x4 (&v)[4], f32x4 (&pv)[4]) {
    const int R = it >> 4, gb = it & 15;
#pragma unroll
    for (int i = 0; i < 4; ++i) { const size_t t = (size_t)R * 32 + 8 * i + tsub; v[i] = *(const u32x4*)(XB + t * DM + 64 * gb + 8 * c8); pv[i] = *(const f32x4*)(SS + t * 32 + 4 * c8); }
}
DI void norm_proc(bf16* UG, int it, int tsub, int c8, const u32x4 (&v)[4], const f32x4 (&pv)[4]) {
    const int R = it >> 4, gb = it & 15, g = 4 * gb + (c8 >> 1);
#pragma unroll
    for (int i = 0; i < 4; ++i) { float sm = (pv[i][0] + pv[i][1]) + (pv[i][2] + pv[i][3]); sm += __shfl_xor(sm, 1); sm += __shfl_xor(sm, 2); sm += __shfl_xor(sm, 4);
        const float rs = __builtin_amdgcn_rsqf(sm * (1.0f / 1024.0f) + 1e-6f); u32x4 o;
        o.x = pk2(bflo(v[i].x) * rs, bfhi(v[i].x) * rs); o.y = pk2(bflo(v[i].y) * rs, bfhi(v[i].y) * rs); o.z = pk2(bflo(v[i].z) * rs, bfhi(v[i].z) * rs); o.w = pk2(bflo(v[i].w) * rs, bfhi(v[i].w) * rs);
        *(u32x4*)(UG + ((size_t)g * 1024 + R) * 640 + (8 * i + tsub) * 16 + 8 * (c8 & 1)) = o; }
}
DI void norm_phase(const Params& P) {
    const int lane = ltid() & 63, wave = __builtin_amdgcn_readfirstlane(ltid() >> 6);
    const bf16* XB = (const bf16*)(lws(P) + WS_XB); const float* SS = (const float*)(lws(P) + WS_SS); bf16* UG = (bf16*)(lws(P) + WS_UG);
    const int tsub = lane >> 3, c8 = lane & 7; const int NGW = gridDim.x * 8; constexpr int NIT = 16384;
    u32x4 va[4], vn[4]; f32x4 pa[4], pn[4];
    int it = lbid() * 8 + wave;
    if (it < NIT) norm_load(XB, SS, it, tsub, c8, va, pa);
    for (; it < NIT; it += NGW) { const int itn = it + NGW; const bool hn = itn < NIT;
        if (hn) norm_load(XB, SS, itn, tsub, c8, vn, pn);
        norm_proc(UG, it, tsub, c8, va, pa);
#pragma unroll
        for (int i = 0; i < 4; ++i) { va[i] = vn[i]; pa[i] = pn[i]; } }
}
DI float gelu_tanh(float x) { const float z = 1.5957691216057308f * (x + 0.044715f * x * x * x); return x * __builtin_amdgcn_rcpf(1.0f + __builtin_amdgcn_exp2f(-1.4426950408889634f * z)); }
constexpr int EP = 132;
__global__ void __launch_bounds__(512, 2) mega(Params P) {
    extern __shared__ __attribute__((aligned(16))) unsigned char lds_raw[];
    LAS unsigned char* lds = (LAS unsigned char*)lds_raw;
    cg::grid_group grid = cg::this_grid();
    volatile LAS unsigned* MISC = (volatile LAS unsigned*)(lds + 135168);
    if (threadIdx.x < 32) MISC[threadIdx.x] = 0u;
    __syncthreads();
    const XcdBarrier bar = xcd_barrier_post((unsigned*)P.ws, MISC + 8);
    if (P.out == nullptr) grid.sync();
    const int G = gridDim.x;
    bf16* XB = (bf16*)(lws(P) + WS_XB); float* SS = (float*)(lws(P) + WS_SS); bf16* ACT = (bf16*)(lws(P) + WS_ACT);
#pragma unroll 1
    for (int pi = 0; pi < NPROG; ++pi) {
        const int step = pi - ((DUP_A >= 0 && pi > DUP_A) ? 1 : 0) - ((DUP_B >= 0 && pi > DUP_B + 1) ? 1 : 0);
        if (step == 0) { if (PHMASK & 1) prologue(P, lds); }
        else if (step == 1 || step == 7 || step == 9 || step == 15) {
            const int ls = (step == 1) ? 0 : (step == 7) ? 1 : (step == 9) ? 2 : 3;
            pg8::Gemm g{XB, (const bf16*)(lws(P) + WS_WGU) + (size_t)ls * 5632 * 1024, NT_, 2 * FF, DM}; pg8::StaticOrder S; S.init(NT_, 2 * FF, G, (int)lbid());
            pg8::EpiSwiGLU E{ACT, SS};
            if (PHMASK & 2) pg8::gemm_phase<pg8::EpiSwiGLU, pg8::StaticOrder, true, true>(lds, g, S, E);
        } else if (step == 2 || step == 6 || step == 8 || step == 10 || step == 16) {
            const int ls = (step == 2) ? 0 : (step == 8) ? 1 : (step == 10) ? 2 : 3;
            const bf16* A = (step == 6) ? (const bf16*)(lws(P) + WS_AO) : ACT;
            const bf16* Bt = (step == 6) ? (const bf16*)(lws(P) + WS_WOUT) : (const bf16*)(lws(P) + WS_WD) + (size_t)ls * 1024 * 2816;
            const int K = (step == 6) ? DM : FF;
            pg8::Gemm g{A, Bt, NT_, DM, K}; pg8::StaticOrder S; S.init(NT_, DM, G, (int)lbid());
            pg8::EpiResid E{(step == 16) ? P.out : (float*)nullptr, XB, SS, (step == 6) ? 1.0f : 0.5f};
            if (PHMASK & 4) pg8::gemm_phase<pg8::EpiResid, pg8::StaticOrder, true, true>(lds, g, S, E);
        } else if (step == 3) {
            pg8::Gemm g{XB, (const bf16*)(lws(P) + WS_WIN), NT_, 2048, DM}; pg8::StaticOrder S; S.init(NT_, 2048, G, (int)lbid());
            pg8::EpiQKVP E{(bf16*)(lws(P) + WS_QKVP), SS, P.in[8], P.in[9], (const float*)(lws(P) + WS_CS), QSCALE};
            if (PHMASK & 8) pg8::gemm_phase<pg8::EpiQKVP, pg8::StaticOrder, true, true>(lds, g, S, E);
        } else if (step == 4) { if (PHMASK & 16) attn_phase_a(P, lds); }
        else if (step == 5) { if (PHMASK & 32) attn_phase_b(P, lds); }
        else if (step == 11) { if (PHMASK & 64) norm_phase(P); }
        else if (step == 12) {
            pg8::Gemm g{(const bf16*)(lws(P) + WS_UG), (const bf16*)(lws(P) + WS_M1), 65536, 256, 512, 640, 512}; pg8::S1Order S; S.G = G; S.c = (int)lbid();
            pg8::EpiS1 E{(bf16*)(lws(P) + WS_UG), (const float*)(lws(P) + WS_A32)};
            if (PHMASK & 128) pg8::gemm_phase<pg8::EpiS1, pg8::S1Order, false, true>(lds, g, S, E);
        }
        else if (step == 13) {
            pg8::Gemm g{(const bf16*)(lws(P) + WS_UG), (const bf16*)(lws(P) + WS_W3), 65536, 512, 640}; pg8::BatchedOrder S; S.G = G; S.c = (int)lbid();
            pg8::EpiS5 E{(bf16*)(lws(P) + WS_Z)};
            if (PHMASK & 128) pg8::gemm_phase<pg8::EpiS5, pg8::BatchedOrder, true, true>(lds, g, S, E);
        }
        else if (step == 14) {
            pg8::Gemm g{(const bf16*)(lws(P) + WS_Z), (const bf16*)(lws(P) + WS_WGLU), NT_, 2048, DM}; pg8::StaticOrder S; S.init(NT_, 2048, G, (int)lbid());
            pg8::EpiGLU E{XB, SS};
            if (PHMASK & 256) pg8::gemm_phase<pg8::EpiGLU, pg8::StaticOrder, true, true>(lds, g, S, E);
        }
        if (pi != NPROG - 1) xcd_barrier(bar);
#ifdef EXTRA_SYNC
        if (pi < 8) xcd_barrier(bar);
#endif
    }
}

extern "C" void kernel_launch(void* const* d_in, const int* in_sizes, int n_in, void* d_out, int out_size, void* d_ws, size_t ws_size, hipStream_t stream) {
    static int grid = 0;
    if (grid == 0) {
        if (n_in != 22 || out_size != NT_ * DM || ws_size < WS_END) { fprintf(stderr, "kernel_launch: unexpected shapes: n_in %d out %d ws %zu\n", n_in, out_size, ws_size); grid = -1; return; }
        int dev = 0, cus = 0, per_cu = 0;
        hipGetDevice(&dev); hipDeviceGetAttribute(&cus, hipDeviceAttributeMultiprocessorCount, dev);
        if (hipFuncSetAttribute((const void*)mega, hipFuncAttributeMaxDynamicSharedMemorySize, LDS_BYTES) != hipSuccess) { fprintf(stderr, "kernel_launch: hipFuncSetAttribute failed\n"); grid = -1; return; }
        if (hipOccupancyMaxActiveBlocksPerMultiprocessor(&per_cu, (const void*)mega, 512, LDS_BYTES) != hipSuccess || per_cu < 1) per_cu = 1;
        (void)hipGetLastError();
        grid = cus * 1;
        (void)per_cu;
    }
    if (grid < 0) return;
    if (hipMemsetAsync(d_ws, 0, 16384, stream) != hipSuccess) { fprintf(stderr, "kernel_launch: memset failed\n"); return; }
    Params p{};
    for (int i = 0; i < 22; ++i) p.in[i] = (const float*)d_in[i];
    p.out = (float*)d_out; p.ws = (unsigned char*)d_ws;
    void* args[] = {&p};
    hipError_t e = hipLaunchCooperativeKernel((const void*)mega, dim3(grid), dim3(512), args, LDS_BYTES, stream);
    if (e != hipSuccess) fprintf(stderr, "cooperative launch failed: %s (grid %d)\n", hipGetErrorString(e), grid);
}
```
